# Optimizing an MI355X kernel written in HIP

```python
import jax, jax.numpy as jnp
from jax import lax
import numpy as np

D_MODEL = 2048
BATCH = 4
SEQ = 2048
DEPTH = 1
DEC_BATCH = 128
DEC_SEQ = 4
PAST_LEN = 16384
PAGE_SIZE = 128

CONV_DIM = D_MODEL // 2
CONV_GROUPS = 8
CONV_WIDTH = 3
SG_DIM = D_MODEL // 2
SG_GROUPS = 8
SG_HEAD = SG_DIM // SG_GROUPS
CHUNK = 128
D_FF = -(-8 * D_MODEL // (3 * 256)) * 256
N_MOD = 6
EPS = 1e-6
IN_SPLITS = (CONV_DIM, CONV_DIM, CONV_DIM, SG_DIM, SG_DIM, D_MODEL, D_MODEL)
IN_COLS = sum(IN_SPLITS)

kernel_name = "hybrid_shortconv_gmlp_decoder_step"


def _rms(x, gain):
    xf = x.astype(jnp.float32)
    y = xf * lax.rsqrt(jnp.mean(xf * xf, axis=-1, keepdims=True) + EPS)
    return (y * gain.astype(jnp.float32)).astype(x.dtype)


def _layer(x, c, conv_prefix, chunk, g_mix, g_ffn, w_ada, b_ada, w_in, w_conv, g_v, w_sg, b_sg,
           w_pa, w_pb, w_out, w_ffn_in, w_ffn_out):
    n, s, _ = x.shape
    mod = (jax.nn.silu(c) @ w_ada + b_ada).reshape(n, N_MOD, 1, D_MODEL)
    sh_m, sc_m, gt_m, sh_f, sc_f, gt_f = [mod[:, i] for i in range(N_MOD)]

    h = _rms(x, g_mix) * (1 + sc_m) + sh_m
    proj = h @ w_in
    idx = np.cumsum(IN_SPLITS)[:-1].tolist()
    b_gate, c_gate, hc, u, v, ga, gb = jnp.split(proj, idx, axis=-1)

    z = c_gate * hc
    zfull = jnp.concatenate([conv_prefix.astype(z.dtype), z], axis=1)
    conv = sum(w_conv[k] * zfull[:, k:k + s] for k in range(CONV_WIDTH))
    ya = b_gate * conv

    u = jax.nn.gelu(u)
    v = _rms(jax.nn.gelu(v), g_v)
    vg = v.reshape(n, s // chunk, chunk, SG_GROUPS, SG_HEAD)
    w_causal = jnp.tril(w_sg[:, :chunk, :chunk])
    sp = jnp.einsum('gts,bnsgc->bntgc', w_causal, vg) + b_sg[:, :chunk].T[None, None, :, :, None]
    yb = u * sp.reshape(n, s, SG_DIM)

    merged = jax.nn.sigmoid(ga) * (ya @ w_pa) + jax.nn.sigmoid(gb) * (yb @ w_pb)
    x = x + gt_m * (merged @ w_out)

    h2 = _rms(x, g_ffn) * (1 + sc_f) + sh_f
    gate, up = jnp.split(h2 @ w_ffn_in, 2, axis=-1)
    x = x + gt_f * ((jax.nn.silu(gate) * up) @ w_ffn_out)

    conv_state = zfull[:, -(CONV_WIDTH - 1):]
    v_rows = vg[:, -1]
    return x, conv_state, v_rows


def setup_inputs(seed: int = 0) -> dict:
    key = jax.random.key(seed)
    ks = jax.random.split(key, 24)
    nrm = lambda k, shape, scale: jax.random.normal(k, shape, jnp.float32) * scale
    L = DEPTH
    return {
        "x_prompt": nrm(ks[0], (BATCH, SEQ, D_MODEL), 1.0),
        "x_sample": nrm(ks[1], (DEC_BATCH, DEC_SEQ, D_MODEL), 1.0),
        "state_conv": nrm(ks[2], (L, DEC_BATCH, CONV_WIDTH - 1, CONV_DIM), 1.0),
        "c_prompt": nrm(ks[3], (BATCH, D_MODEL), 1.0),
        "c_sample": nrm(ks[4], (DEC_BATCH, D_MODEL), 1.0),
        "g_mix": 1.0 + nrm(ks[5], (L, D_MODEL), 0.02),
        "g_ffn": 1.0 + nrm(ks[6], (L, D_MODEL), 0.02),
        "w_ada": nrm(ks[7], (L, D_MODEL, N_MOD * D_MODEL), 0.5 * D_MODEL ** -0.5),
        "b_ada": nrm(ks[8], (L, N_MOD * D_MODEL), 0.02),
        "w_in": nrm(ks[9], (L, D_MODEL, IN_COLS), D_MODEL ** -0.5),
        "w_conv": nrm(ks[10], (L, CONV_WIDTH, CONV_DIM), CONV_WIDTH ** -0.5),
        "g_v": 1.0 + nrm(ks[11], (L, SG_DIM), 0.02),
        "w_sg": nrm(ks[12], (L, SG_GROUPS, CHUNK, CHUNK), CHUNK ** -0.5),
        "b_sg": 1.0 + nrm(ks[13], (L, SG_GROUPS, CHUNK), 0.02),
        "w_pa": nrm(ks[14], (L, CONV_DIM, D_MODEL), CONV_DIM ** -0.5),
        "w_pb": nrm(ks[15], (L, SG_DIM, D_MODEL), SG_DIM ** -0.5),
        "w_out": nrm(ks[16], (L, D_MODEL, D_MODEL), D_MODEL ** -0.5),
        "w_ffn_in": nrm(ks[17], (L, D_MODEL, 2 * D_FF), D_MODEL ** -0.5),
        "w_ffn_out": nrm(ks[18], (L, D_FF, D_MODEL), D_FF ** -0.5),
        "g_final": 1.0 + nrm(ks[19], (D_MODEL,), 0.02),
    }


def reference(x_prompt, x_sample, state_conv, c_prompt, c_sample, g_mix, g_ffn, w_ada, b_ada,
              w_in, w_conv, g_v, w_sg, b_sg, w_pa, w_pb, w_out, w_ffn_in, w_ffn_out, g_final):
    xp, xs = x_prompt, x_sample
    conv_p, conv_s, sgv_p, sgv_s = [], [], [], []
    for l in range(DEPTH):
        params = (g_mix[l], g_ffn[l], w_ada[l], b_ada[l], w_in[l], w_conv[l], g_v[l], w_sg[l],
                  b_sg[l], w_pa[l], w_pb[l], w_out[l], w_ffn_in[l], w_ffn_out[l])
        zero_prefix = jnp.zeros((xp.shape[0], CONV_WIDTH - 1, CONV_DIM), xp.dtype)
        xp, cp, vp = _layer(xp, c_prompt, zero_prefix, CHUNK, *params)
        xs, cs, vs = _layer(xs, c_sample, state_conv[l], xs.shape[1], *params)
        conv_p.append(cp); conv_s.append(cs); sgv_p.append(vp); sgv_s.append(vs)
    y_prompt = _rms(xp, g_final)
    y_sample = _rms(xs, g_final)
    return (y_prompt, y_sample, jnp.stack(conv_p), jnp.stack(conv_s), jnp.stack(sgv_p), jnp.stack(sgv_s))
```

```cpp
#include <hip/hip_runtime.h>
#include <hip/hip_cooperative_groups.h>
#include <cstdio>
#include <cstdint>
namespace cg = cooperative_groups;

#define LAS __attribute__((address_space(3)))
typedef unsigned short bf16_t;
typedef short bf16x8 __attribute__((ext_vector_type(8)));
typedef float f32x4 __attribute__((ext_vector_type(4)));
typedef unsigned u32x4 __attribute__((ext_vector_type(4)));
typedef unsigned u32x2 __attribute__((ext_vector_type(2)));

#define PROBE_PHASE -1
#ifndef MK_N_LAUNCHES
#define MK_N_LAUNCHES 1
#endif

constexpr int D = 2048, MP = 8192, MS = 512, M = MP + MS, SEQ = 2048, NBP = 4, NBS = 128, DSEQ = 4;
constexpr int CD = 1024, NIN = 9216, DFF = 5632, NFI = 2 * DFF, NMOD = 6 * D, MODROWS = NBP + NBS;
constexpr float EPS = 1e-6f;
constexpr int NPHASE = 10;
constexpr int P5_SPLIT = 8, P8_SPLIT = 11;
constexpr size_t O_Y = 0, O_CONVP = (size_t)M * D, O_CONVS = O_CONVP + (size_t)NBP * 2 * CD, O_SGVP = O_CONVS + (size_t)NBS * 2 * CD, O_SGVS = O_SGVP + (size_t)NBP * 128 * 1024;
constexpr size_t al4k(size_t x) { return (x + 4095) & ~(size_t)4095; }
constexpr size_t WS_CTL = 0, CTL_BYTES = 131072;
constexpr size_t WS_MOD = 131072;
constexpr int CW_BAR = 4096, CW_VSS = 16384;
constexpr size_t WS_WIN = al4k(WS_MOD + (size_t)MODROWS * NMOD * 4);
constexpr size_t WS_WPA = al4k(WS_WIN + (size_t)NIN * D * 2);
constexpr size_t WS_WPB = al4k(WS_WPA + (size_t)D * CD * 2);
constexpr size_t WS_WOUT = al4k(WS_WPB + (size_t)D * CD * 2);
constexpr size_t WS_WFI = al4k(WS_WOUT + (size_t)D * D * 2);
constexpr size_t WS_WFO = al4k(WS_WFI + (size_t)NFI * D * 2);
constexpr size_t WS_H = al4k(WS_WFO + (size_t)D * DFF * 2);
constexpr size_t WS_MRG = al4k(WS_H + (size_t)M * D * 2);
constexpr size_t WS_R1 = al4k(WS_MRG + (size_t)M * D * 2);
constexpr size_t WS_BG = WS_R1;
constexpr size_t WS_Z = WS_BG + (size_t)M * CD * 2;
constexpr size_t WS_U = WS_Z + (size_t)M * CD * 2;
constexpr size_t WS_V = WS_U + (size_t)M * CD * 2;
constexpr size_t WS_GA = WS_V + (size_t)M * CD * 2;
constexpr size_t WS_GB = WS_GA + (size_t)M * D * 2;
constexpr size_t WS_YA = WS_GB + (size_t)M * D * 2;
constexpr size_t WS_YB = WS_YA + (size_t)M * CD * 2;
constexpr size_t WS_R1_END = WS_YB + (size_t)M * CD * 2;
constexpr size_t WS_ACT = WS_R1;
constexpr size_t WS_END = (WS_R1_END > WS_ACT + (size_t)M * DFF * 2) ? WS_R1_END : WS_ACT + (size_t)M * DFF * 2;
static_assert(WS_ACT + (size_t)M * DFF * 2 + (size_t)P5_SPLIT * MS * D * 4 + (size_t)M * D * 2 <= WS_R1_END, "ACT + PART5 + XB overlay fits");
static_assert(WS_MRG == WS_H + (size_t)M * D * 2 && WS_R1 >= WS_H + (size_t)P8_SPLIT * MS * D * 4, "PART8 overlay fits");
static_assert((D / 128) % P5_SPLIT == 0 && (DFF / 128) % P8_SPLIT == 0 && 16 * P5_SPLIT <= 256 && 16 * P8_SPLIT <= 256, "piece geometry");

constexpr int LDS_BYTES = 147456;
constexpr int NTHREADS = 512;

__device__ __forceinline__ unsigned cvt_pk_bf16(float lo, float hi) { unsigned r; asm volatile("v_cvt_pk_bf16_f32 %0, %1, %2" : "=v"(r) : "v"(lo), "v"(hi)); return r; }
__device__ __forceinline__ float bf_lo(unsigned w) { return __uint_as_float(w << 16); }
__device__ __forceinline__ float bf_hi(unsigned w) { return __uint_as_float(w & 0xffff0000u); }
__device__ __forceinline__ float sigmoidf_(float x) { return __builtin_amdgcn_rcpf(1.0f + __expf(-x)); }
__device__ __forceinline__ float siluf_(float x) { return x * sigmoidf_(x); }
__device__ __forceinline__ float gelu_tanh(float x) { return x * sigmoidf_(1.5957691216057308f * (x + 0.044715f * x * x * x)); }
__device__ __forceinline__ float wave_sum(float v) {
#pragma unroll
    for (int o = 1; o < 64; o <<= 1) v += __shfl_xor(v, o);
    return v;
}
__device__ __forceinline__ int mod_row(int r) { return r < MP ? (r >> 11) : NBP + ((r - MP) >> 2); }


#define XB_TMO      128
#define XB_XCNT(j)  (256  + 64 * (j))
#define XB_XSUB(j)  (1280 + 64 * (j))
#define XB_XGEN(j)  (2304 + 64 * (j))
#define XB_TOP      3328
#define XB_TOPGEN   3392
#define XCD_BAR_WORDS 3456
#define XB_SPIN_CAP (1u << 18)
__device__ __forceinline__ unsigned xb_ld(unsigned* p)              { return __hip_atomic_load(p, __ATOMIC_RELAXED, __HIP_MEMORY_SCOPE_AGENT); }
__device__ __forceinline__ unsigned xb_add(unsigned* p, unsigned v) { return __hip_atomic_fetch_add(p, v, __ATOMIC_RELAXED, __HIP_MEMORY_SCOPE_AGENT); }
__device__ __forceinline__ unsigned xb_xcc_id() { return (unsigned)__builtin_amdgcn_s_getreg((3 << 11) | 20) & 0xFu; }
#define XB_SPIN(cond, bar) do { unsigned _sp = 0; while (cond) { __builtin_amdgcn_s_sleep(1); \
    if ((++_sp & 255u) == 0u) { if (xb_ld(&(bar)[XB_TMO])) break; if (_sp > XB_SPIN_CAP) { atomicAdd(&(bar)[XB_TMO], 1u); break; } } } } while (0)
struct XcdBarrier { unsigned* bar; unsigned x; volatile LAS unsigned* st; };
__device__ __forceinline__ XcdBarrier xcd_barrier_post(unsigned* bar, volatile LAS unsigned* st) {
    XcdBarrier b; b.bar = bar; b.x = xb_xcc_id(); b.st = st;
    if (threadIdx.x == 0) (void)xb_add(&bar[XB_XCNT(b.x)], 1u);
    return b;
}
__device__ __forceinline__ void xcd_barrier_complete(unsigned* bar, unsigned x, unsigned& nloc, unsigned& nx) {
    const unsigned G = gridDim.x * gridDim.y * gridDim.z;
    unsigned sum, cnt, mine, sp = 0u;
    for (;;) {
        sum = 0u; cnt = 0u; mine = 0u;
#pragma unroll
        for (unsigned j = 0; j < 16; ++j) { const unsigned c = xb_ld(&bar[XB_XCNT(j)]); sum += c; cnt += (c > 0u) ? 1u : 0u; mine = (j == x) ? c : mine; }
        if (sum == G) break;
        __builtin_amdgcn_s_sleep(1);
        if ((++sp & 255u) == 0u) { if (xb_ld(&bar[XB_TMO])) break; if (sp > XB_SPIN_CAP) { atomicAdd(&bar[XB_TMO], 1u); break; } }
    }
    nloc = mine > 0u ? mine : 1u; nx = cnt > 0u ? cnt : 1u;
}
__device__ __forceinline__ void xcd_barrier(const XcdBarrier& b) {
    asm volatile("s_waitcnt vmcnt(0)" ::: "memory");
    __syncthreads();
    if (threadIdx.x == 0) {
        unsigned* bar = b.bar;
        __builtin_amdgcn_s_waitcnt(0);
        unsigned nloc = b.st[0], nx = b.st[1];
        if (nloc == 0u) { xcd_barrier_complete(bar, b.x, nloc, nx); b.st[0] = nloc; b.st[1] = nx; }
        const unsigned old = xb_add(&bar[XB_XSUB(b.x)], 1u);
        const unsigned gen = old / nloc;
        if (old + 1u == (gen + 1u) * nloc) {
            __builtin_amdgcn_fence(__ATOMIC_RELEASE, "agent");
            asm volatile("s_waitcnt vmcnt(0)" ::: "memory");
            const unsigned og = xb_add(&bar[XB_TOP], 1u);
            const unsigned tg = og / nx;
            if (og + 1u == (tg + 1u) * nx) xb_add(&bar[XB_TOPGEN], 1u);
            else XB_SPIN(xb_ld(&bar[XB_TOPGEN]) == tg, bar);
            __builtin_amdgcn_fence(__ATOMIC_ACQUIRE, "agent");
            xb_add(&bar[XB_XGEN(b.x)], 1u);
            asm volatile("s_waitcnt vmcnt(0)" ::: "memory");
        } else {
            XB_SPIN(xb_ld(&bar[XB_XGEN(b.x)]) == gen, bar);
            __builtin_amdgcn_fence(__ATOMIC_ACQUIRE, "agent");
            asm volatile("s_waitcnt vmcnt(0)" ::: "memory");
        }
    }
    __syncthreads();
}

namespace pg8 {
constexpr int BM = 256, BK = 64, HALF = 128, HTB = HALF * BK * 2, STAGE_BYTES = 8 * HTB, NXCD = 8, WGM = 8;
__host__ __device__ __forceinline__ int lds_byte(int r, int c) { const int st = (r >> 4) * 2 + (c >> 5), rr = r & 15, cc = c & 31, ob = rr * 64 + cc * 2; return st * 1024 + (ob ^ (((ob >> 9) & 1) << 5)); }
__host__ __device__ __forceinline__ void stage_rc(int b, int& R, int& C) { const int st = b / 1024, sb = b % 1024, swz = sb ^ (((sb >> 9) & 1) << 5); R = (st >> 1) * 16 + swz / 64; C = (st & 1) * 32 + (swz % 64) / 2; }
__host__ __device__ __forceinline__ int perm32(int rho) { const int n = rho >> 4, i = rho & 15; return 8 * (i >> 2) + 4 * n + (i & 3); }

struct Unit { const char* A; const char* B; int nk, pm, pn, aux, keep; };

struct TileOrder {
    int nM, nN, nwg, G, c;
    __device__ void init(int nM_, int nN_, int G_, int c_) { nM = nM_; nN = nN_; nwg = nM * nN; G = G_; c = c_; }
    __device__ bool tile(int i, int& pm, int& pn) const {
        const long L = (long)i * G + c; if (L >= nwg) return false;
        int wgid = (int)L; { const int q = nwg / NXCD, r = nwg % NXCD, xcd = wgid % NXCD, off = wgid / NXCD; wgid = (xcd < r ? xcd * (q + 1) : r * (q + 1) + (xcd - r) * q) + off; }
        const int nig = WGM * nN, gid = wgid / nig, fm = gid * WGM, gsz = (nM - fm) < WGM ? (nM - fm) : WGM;
        pm = fm + ((wgid % nig) % gsz); pn = (wgid % nig) / gsz; return true;
    }
};
struct SchedPlain {
    TileOrder o; const char* A; const char* B; size_t tsA, tsB; int nk;
    __device__ bool next(int i, Unit& u) const { int pm, pn; if (!o.tile(i, pm, pn)) return false; u.A = A + (size_t)pm * tsA; u.B = B + (size_t)pn * tsB; u.nk = nk; u.pm = pm; u.pn = pn; u.aux = 0; u.keep = 0; return true; }
};
struct SchedDual {
    TileOrder o; const char* A0; const char* B0; const char* A1; const char* B1; size_t tsA, tsB; int nk;
    __device__ bool next(int i, Unit& u) const { int pm, pn; if (!o.tile(i >> 1, pm, pn)) return false; const int s = i & 1;
        u.A = (s ? A1 : A0) + (size_t)pm * tsA; u.B = (s ? B1 : B0) + (size_t)pn * tsB; u.nk = nk; u.pm = pm; u.pn = pn; u.aux = s; u.keep = !s; return true; }
};

struct SchedSplit {
    TileOrder o; int S, PP, G, c; const char* A; const char* B; size_t tsA, tsB; int nkfull;
    __device__ void init(int nN, int S_, int PP_, int nkfull_, int G_, int c_) { o.init(MP / 256, nN, G_, c_); S = S_; PP = PP_; G = G_; c = c_; nkfull = nkfull_; }
    __device__ bool next(int i, Unit& u) const {
        const int R = (o.nwg - c + G - 1) / G;
        if (i < R) { int pm, pn; o.tile(i, pm, pn); u.A = A + (size_t)pm * tsA; u.B = B + (size_t)pn * tsB; u.nk = nkfull; u.pm = pm; u.pn = pn; u.aux = 0; u.keep = 0; return true; }
        const int idx = c + (i - R) * G; if (idx >= 2 * o.nN * S) return false;
        const int j = idx / S, sp = idx % S; u.pm = MP / 256 + j / o.nN; u.pn = j % o.nN;
        u.A = A + (size_t)u.pm * tsA + (size_t)sp * PP * 256; u.B = B + (size_t)u.pn * tsB + (size_t)sp * PP * 256; u.nk = 2 * PP; u.aux = 1 + sp; u.keep = 0; return true;
    }
};

template <class Epi, class Sched>
__device__ __forceinline__ void gemm_phase(LAS unsigned char* lds, int lda, int ldb, const Sched& S, const Epi& E) {
    const int tid = threadIdx.x, wid = __builtin_amdgcn_readfirstlane(tid >> 6), lane = tid & 63, wr = wid >> 2, wc = wid & 3, fr = lane & 15, fq = lane >> 4;
    unsigned voffA[2], voffB[2];
#pragma unroll
    for (int i = 0; i < 2; ++i) { int R, C; stage_rc(tid * 16 + i * 8192, R, C); const int Rb = Epi::PERM ? ((R & ~31) + perm32(R & 31)) : R;
        voffA[i] = (unsigned)(R * lda + C) * 2u; voffB[i] = (unsigned)(Rb * ldb + C) * 2u; }
    const size_t kstep = (size_t)(BK * 2);
    const size_t hstepA = (size_t)HALF * lda * 2, hstepB = (size_t)HALF * ldb * 2;
    const unsigned ldsw = (unsigned)wid * 1024u;
    const int aoff = lds_byte(wr * 64 + fr, fq * 8), boff = lds_byte(wc * 32 + fr, fq * 8);
#define PG8_SA(b, h) (((b) * 2 + (h)) * HTB)
#define PG8_SB(b, h) ((4 + (b) * 2 + (h)) * HTB)
#define PG8_STAGE(bufoff, gbase, voff) do { _Pragma("unroll") for (int _i = 0; _i < 2; ++_i) \
        __builtin_amdgcn_global_load_lds((const unsigned*)((const char*)(gbase) + (voff)[_i]), (LAS unsigned*)(lds + (bufoff) + ldsw + _i * 8192), 16, 0, 0); } while (0)
#define PG8_LDA(dst, b, h) do { _Pragma("unroll") for (int m = 0; m < 4; ++m) _Pragma("unroll") for (int k = 0; k < 2; ++k) dst[m][k] = *(const LAS bf16x8*)(lds + PG8_SA(b, h) + aoff + m * 2048 + k * 1024); } while (0)
#define PG8_LDB(dst, b, h) do { _Pragma("unroll") for (int n = 0; n < 2; ++n) _Pragma("unroll") for (int k = 0; k < 2; ++k) dst[n][k] = *(const LAS bf16x8*)(lds + PG8_SB(b, h) + boff + n * 2048 + k * 1024); } while (0)
#define PG8_MMA(ai, bj, At, Bt) do { __builtin_amdgcn_s_setprio(1); _Pragma("unroll") for (int m = 0; m < 4; ++m) _Pragma("unroll") for (int n = 0; n < 2; ++n) _Pragma("unroll") for (int k = 0; k < 2; ++k) \
        acc[ai][bj][m][n] = __builtin_amdgcn_mfma_f32_16x16x32_bf16(Bt[n][k], At[m][k], acc[ai][bj][m][n], 0, 0, 0); __builtin_amdgcn_s_setprio(0); } while (0)
#define PG8_WAIT_V(n) asm volatile("s_waitcnt vmcnt(" #n ")" ::: "memory")
#define PG8_WAIT_L(n) asm volatile("s_waitcnt lgkmcnt(" #n ")" ::: "memory")
#define PG8_BAR __builtin_amdgcn_s_barrier()
#define PG8_SCHED __builtin_amdgcn_sched_barrier(0)
    Unit cur, nxt; int ui = 0;
    if (!S.next(0, cur)) return;
    f32x4 acc[2][2][4][2];
#pragma unroll
    for (int a = 0; a < 2; ++a)
#pragma unroll
        for (int b = 0; b < 2; ++b)
#pragma unroll
            for (int m = 0; m < 4; ++m)
#pragma unroll
                for (int n = 0; n < 2; ++n) acc[a][b][m][n] = (f32x4){0.f, 0.f, 0.f, 0.f};
    bf16x8 At[4][2], B0[2][2], B1[2][2];
    const char* cA = cur.A; const char* cB = cur.B;
    PG8_STAGE(PG8_SB(0, 0), cB, voffB); PG8_STAGE(PG8_SB(0, 1), cB + hstepB, voffB); PG8_STAGE(PG8_SA(0, 0), cA, voffA); PG8_STAGE(PG8_SA(0, 1), cA + hstepA, voffA);
    if (wr == 1) PG8_BAR;
    PG8_WAIT_V(2); PG8_BAR;
    PG8_STAGE(PG8_SB(1, 0), cB + kstep, voffB); PG8_STAGE(PG8_SA(1, 0), cA + kstep, voffA); PG8_STAGE(PG8_SB(1, 1), cB + hstepB + kstep, voffB);
    PG8_WAIT_V(6); PG8_BAR;
    for (;;) {
        const bool has_next = S.next(ui + 1, nxt);
        const char* nA = has_next ? nxt.A : cA; const char* nB = has_next ? nxt.B : cB;
        const int nt = cur.nk;
        for (int t = 0; t < nt; t += 2) {
            const bool last = (t == nt - 2);
            const char* a1 = cA + (size_t)(t + 1) * kstep;
            const char* a2 = last ? nA : cA + (size_t)(t + 2) * kstep; const char* b2 = last ? nB : cB + (size_t)(t + 2) * kstep;
            const char* a3 = a2 + kstep; const char* b3 = b2 + kstep;
            PG8_LDB(B0, 0, 0); PG8_LDB(B1, 0, 1); PG8_SCHED; PG8_LDA(At, 0, 0); PG8_STAGE(PG8_SA(1, 1), a1 + hstepA, voffA);
            PG8_WAIT_V(8); PG8_WAIT_L(0); PG8_BAR; PG8_MMA(0, 0, At, B0); PG8_MMA(0, 1, At, B1); PG8_BAR; PG8_SCHED;
            PG8_LDA(At, 0, 1); PG8_STAGE(PG8_SB(0, 0), b2, voffB); PG8_STAGE(PG8_SB(0, 1), b2 + hstepB, voffB); PG8_STAGE(PG8_SA(0, 0), a2, voffA);
            PG8_WAIT_V(8); PG8_WAIT_L(0); PG8_BAR; PG8_MMA(1, 0, At, B0); PG8_MMA(1, 1, At, B1); PG8_BAR; PG8_SCHED;
            PG8_LDB(B0, 1, 0); PG8_LDB(B1, 1, 1); PG8_SCHED; PG8_LDA(At, 1, 0); PG8_STAGE(PG8_SA(0, 1), a2 + hstepA, voffA);
            PG8_WAIT_V(8); PG8_WAIT_L(0); PG8_BAR; PG8_MMA(0, 0, At, B0); PG8_MMA(0, 1, At, B1); PG8_BAR; PG8_SCHED;
            PG8_LDA(At, 1, 1); PG8_STAGE(PG8_SB(1, 0), b3, voffB); PG8_STAGE(PG8_SB(1, 1), b3 + hstepB, voffB); PG8_STAGE(PG8_SA(1, 0), a3, voffA);
            PG8_WAIT_V(8); PG8_WAIT_L(0); PG8_BAR; PG8_MMA(1, 0, At, B0); PG8_MMA(1, 1, At, B1); PG8_BAR; PG8_SCHED;
        }
        if (wr == 0) PG8_BAR;
        E(acc, cur, wr, wc, fr, fq);
        if (!has_next) break;
        if (!cur.keep) {
#pragma unroll
            for (int a = 0; a < 2; ++a)
#pragma unroll
                for (int b = 0; b < 2; ++b)
#pragma unroll
                    for (int m = 0; m < 4; ++m)
#pragma unroll
                        for (int n = 0; n < 2; ++n) acc[a][b][m][n] = (f32x4){0.f, 0.f, 0.f, 0.f};
        }
        cur = nxt; cA = nA; cB = nB; ++ui;
        if (wr == 1) PG8_BAR;
    }
    PG8_WAIT_V(0);
    PG8_BAR;
#undef PG8_SA
#undef PG8_SB
#undef PG8_STAGE
#undef PG8_LDA
#undef PG8_LDB
#undef PG8_MMA
#undef PG8_WAIT_V
#undef PG8_WAIT_L
#undef PG8_BAR
#undef PG8_SCHED
}

__device__ __forceinline__ void st8(bf16_t* p, f32x4 v0, f32x4 v1) {
    u32x4 w; w.x = cvt_pk_bf16(v0[0], v0[1]); w.y = cvt_pk_bf16(v0[2], v0[3]); w.z = cvt_pk_bf16(v1[0], v1[1]); w.w = cvt_pk_bf16(v1[2], v1[3]);
    *(u32x4*)p = w;
}
template <int ACT> __device__ __forceinline__ f32x4 act4(f32x4 v) {
    if (ACT == 1) { return (f32x4){gelu_tanh(v[0]), gelu_tanh(v[1]), gelu_tanh(v[2]), gelu_tanh(v[3])}; }
    if (ACT == 2) { return (f32x4){sigmoidf_(v[0]), sigmoidf_(v[1]), sigmoidf_(v[2]), sigmoidf_(v[3])}; }
    return v;
}
struct EpiIn {
    static constexpr bool PERM = true;
    bf16_t *BG, *Z, *U, *V, *GA, *GB; float* VSS;
    __device__ __forceinline__ void operator()(f32x4 (&acc)[2][2][4][2], const Unit& u, int wr, int wc, int fr, int fq) const {
        const int row0 = u.pm * BM + wr * 64 + fr, cl = wc * 32 + 8 * fq, pn = u.pn;
        bf16_t* dst; int ld, mode, coff;
        if (pn < 4) { dst = BG; ld = CD; mode = 0; coff = pn * 256; }
        else if (pn < 12) { dst = Z; ld = CD; mode = 3; coff = (pn - 4) * 128; }
        else if (pn < 16) { dst = U; ld = CD; mode = 1; coff = (pn - 12) * 256; }
        else if (pn < 20) { dst = V; ld = CD; mode = 1; coff = (pn - 16) * 256; }
        else if (pn < 28) { dst = GA; ld = D; mode = 2; coff = (pn - 20) * 256; }
        else { dst = GB; ld = D; mode = 2; coff = (pn - 28) * 256; }
        bf16_t* base = dst + (size_t)row0 * ld + coff + cl; const bool isv = (pn >= 16 && pn < 20);
        if (mode == 3) {
#pragma unroll
            for (int ai = 0; ai < 2; ++ai)
#pragma unroll
                for (int m = 0; m < 4; ++m) { st8(base + (size_t)(ai * HALF + m * 16) * ld, acc[ai][0][m][0] * acc[ai][1][m][0], acc[ai][0][m][1] * acc[ai][1][m][1]); asm volatile("" ::: "memory"); }
        } else {
#pragma unroll
            for (int ai = 0; ai < 2; ++ai)
#pragma unroll
                for (int m = 0; m < 4; ++m) { bf16_t* rowp = base + (size_t)(ai * HALF + m * 16) * ld; float ss = 0.f;
#pragma unroll
                    for (int bj = 0; bj < 2; ++bj) { f32x4 v0 = acc[ai][bj][m][0], v1 = acc[ai][bj][m][1];
                        if (mode == 1) { v0 = act4<1>(v0); v1 = act4<1>(v1); } else if (mode == 2) { v0 = act4<2>(v0); v1 = act4<2>(v1); }
                        st8(rowp + bj * HALF, v0, v1);
                        if (isv) ss += (v0[0] * v0[0] + v0[1] * v0[1]) + (v0[2] * v0[2] + v0[3] * v0[3]) + (v1[0] * v1[0] + v1[1] * v1[1]) + (v1[2] * v1[2] + v1[3] * v1[3]); }
                    if (isv) { ss += __shfl_xor(ss, 16); ss += __shfl_xor(ss, 32); if (fq == 0) __hip_atomic_fetch_add(VSS + row0 + ai * HALF + m * 16, ss, __ATOMIC_RELAXED, __HIP_MEMORY_SCOPE_AGENT); }
                    asm volatile("" ::: "memory"); }
        }
    }
};
struct EpiMerge {
    static constexpr bool PERM = true;
    const bf16_t *GA, *GB; bf16_t* MRG;
    __device__ __forceinline__ void operator()(f32x4 (&acc)[2][2][4][2], const Unit& u, int wr, int wc, int fr, int fq) const {
        const int row0 = u.pm * BM + wr * 64 + fr, col0 = u.pn * BM + wc * 32 + 8 * fq;
        if (u.aux == 0) {
#pragma unroll
            for (int ai = 0; ai < 2; ++ai)
#pragma unroll
                for (int m = 0; m < 4; ++m) { const size_t off = (size_t)(row0 + ai * HALF + m * 16) * D + col0;
#pragma unroll
                    for (int bj = 0; bj < 2; ++bj) {
                        const u32x4 gb = *(const u32x4*)(GB + off + bj * HALF), ga = *(const u32x4*)(GA + off + bj * HALF);
                        const f32x4 b0 = (f32x4){bf_lo(gb.x), bf_hi(gb.x), bf_lo(gb.y), bf_hi(gb.y)}, b1 = (f32x4){bf_lo(gb.z), bf_hi(gb.z), bf_lo(gb.w), bf_hi(gb.w)};
                        const f32x4 a0 = (f32x4){bf_lo(ga.x), bf_hi(ga.x), bf_lo(ga.y), bf_hi(ga.y)}, a1 = (f32x4){bf_lo(ga.z), bf_hi(ga.z), bf_lo(ga.w), bf_hi(ga.w)};
#pragma unroll
                        for (int j = 0; j < 4; ++j) { acc[ai][bj][m][0][j] *= a0[j] * __builtin_amdgcn_rcpf(fmaxf(b0[j], 1e-20f)); acc[ai][bj][m][1][j] *= a1[j] * __builtin_amdgcn_rcpf(fmaxf(b1[j], 1e-20f)); }
                    } }
        } else {
            u32x4 cgb[2];
#pragma unroll
            for (int bj = 0; bj < 2; ++bj) cgb[bj] = *(const u32x4*)(GB + (size_t)row0 * D + col0 + bj * HALF);
#pragma unroll
            for (int ai = 0; ai < 2; ++ai)
#pragma unroll
                for (int m = 0; m < 4; ++m) { const size_t off = (size_t)(row0 + ai * HALF + m * 16) * D + col0;
                    u32x4 ngb[2];
                    if (ai * 4 + m < 7) { const int g2 = ai * 4 + m + 1; const size_t off2 = (size_t)(row0 + (g2 >> 2) * HALF + (g2 & 3) * 16) * D + col0;
#pragma unroll
                        for (int bj = 0; bj < 2; ++bj) ngb[bj] = *(const u32x4*)(GB + off2 + bj * HALF); }
#pragma unroll
                    for (int bj = 0; bj < 2; ++bj) { const u32x4 gb = cgb[bj];
                        f32x4 b0 = (f32x4){bf_lo(gb.x), bf_hi(gb.x), bf_lo(gb.y), bf_hi(gb.y)}, b1 = (f32x4){bf_lo(gb.z), bf_hi(gb.z), bf_lo(gb.w), bf_hi(gb.w)};
#pragma unroll
                        for (int j = 0; j < 4; ++j) { b0[j] = fmaxf(b0[j], 1e-20f); b1[j] = fmaxf(b1[j], 1e-20f); }
                        st8(MRG + off + bj * HALF, acc[ai][bj][m][0] * b0, acc[ai][bj][m][1] * b1); }
#pragma unroll
                    for (int bj = 0; bj < 2; ++bj) cgb[bj] = ngb[bj];
                }
        }
    }
};
template <bool BASE_BF16> struct EpiResidSplit {
    static constexpr bool PERM = true;
    const void* base; bf16_t* XB; bf16_t* PART; const float* gate;
    __device__ __forceinline__ void ld(int r, int col0, bool piece, f32x4 (&b)[2][2], f32x4 (&g)[2][2]) const {
        const float* gp = gate + (size_t)mod_row(r) * NMOD + col0;
#pragma unroll
        for (int bj = 0; bj < 2; ++bj) { g[bj][0] = *(const f32x4*)(gp + bj * HALF); g[bj][1] = *(const f32x4*)(gp + bj * HALF + 4);
            if (piece) { b[bj][0] = (f32x4){0.f, 0.f, 0.f, 0.f}; b[bj][1] = b[bj][0]; }
            else if (BASE_BF16) { const u32x4 p = *(const u32x4*)((const bf16_t*)base + (size_t)r * D + col0 + bj * HALF); b[bj][0] = (f32x4){bf_lo(p.x), bf_hi(p.x), bf_lo(p.y), bf_hi(p.y)}; b[bj][1] = (f32x4){bf_lo(p.z), bf_hi(p.z), bf_lo(p.w), bf_hi(p.w)}; }
            else { const float* bp = (const float*)base + (size_t)r * D + col0 + bj * HALF; b[bj][0] = __builtin_nontemporal_load((const f32x4*)bp); b[bj][1] = __builtin_nontemporal_load((const f32x4*)(bp + 4)); } }
    }
    __device__ __forceinline__ void operator()(f32x4 (&acc)[2][2][4][2], const Unit& u, int wr, int wc, int fr, int fq) const {
        const int row0 = u.pm * BM + wr * 64 + fr, col0 = u.pn * BM + wc * 32 + 8 * fq;
        const bool piece = u.aux != 0;
        f32x4 cb[2][2], cg[2][2];
        ld(row0, col0, piece, cb, cg);
#pragma unroll
        for (int ai = 0; ai < 2; ++ai)
#pragma unroll
            for (int m = 0; m < 4; ++m) { const int r = row0 + ai * HALF + m * 16;
                f32x4 nb[2][2], ng[2][2];
                if (ai * 4 + m < 7) { const int g2 = ai * 4 + m + 1; ld(row0 + (g2 >> 2) * HALF + (g2 & 3) * 16, col0, piece, nb, ng); }
                if (piece) { bf16_t* op = PART + ((size_t)(u.aux - 1) * MS + (size_t)(r - MP)) * D + col0;
#pragma unroll
                    for (int bj = 0; bj < 2; ++bj) st8(op + bj * HALF, cg[bj][0] * acc[ai][bj][m][0], cg[bj][1] * acc[ai][bj][m][1]);
                } else { bf16_t* op = XB + (size_t)r * D + col0;
#pragma unroll
                    for (int bj = 0; bj < 2; ++bj) st8(op + bj * HALF, cb[bj][0] + cg[bj][0] * acc[ai][bj][m][0], cb[bj][1] + cg[bj][1] * acc[ai][bj][m][1]); }
#pragma unroll
                for (int bj = 0; bj < 2; ++bj)
#pragma unroll
                    for (int n = 0; n < 2; ++n) { cb[bj][n] = nb[bj][n]; cg[bj][n] = ng[bj][n]; }
            }
    }
};
struct EpiSwiglu {
    static constexpr bool PERM = true;
    bf16_t* ACT;
    __device__ __forceinline__ void operator()(f32x4 (&acc)[2][2][4][2], const Unit& u, int wr, int wc, int fr, int fq) const {
        bf16_t* base = ACT + (size_t)(u.pm * BM + wr * 64 + fr) * DFF + u.pn * 128 + wc * 32 + 8 * fq;
#pragma unroll
        for (int ai = 0; ai < 2; ++ai)
#pragma unroll
            for (int m = 0; m < 4; ++m) { f32x4 v0, v1;
#pragma unroll
                for (int j = 0; j < 4; ++j) { v0[j] = siluf_(acc[ai][0][m][0][j]) * acc[ai][1][m][0][j]; v1[j] = siluf_(acc[ai][0][m][1][j]) * acc[ai][1][m][1][j]; }
                st8(base + (size_t)(ai * HALF + m * 16) * DFF, v0, v1); }
    }
};
}

struct Args {
    const float *x_prompt, *x_sample, *state_conv, *c_prompt, *c_sample, *g_mix, *g_ffn, *w_ada, *b_ada, *w_in, *w_conv, *g_v, *w_sg, *b_sg, *w_pa, *w_pb, *w_out, *w_ffn_in, *w_ffn_out, *g_final;
    float* out; unsigned char* ws; int ph_lo, ph_hi, li, pad;
};

struct CopyItem { const float* W; bf16_t* WT; int K, N, k0, n0, drow0; };
__device__ __forceinline__ void copy_load(const CopyItem& c, f32x4 (&v)[16], int lane) {
    const int nl = lane & 15, q = lane >> 4;
#pragma unroll
    for (int i = 0; i < 16; ++i) v[i] = __builtin_nontemporal_load((const f32x4*)(c.W + (size_t)(c.k0 + 16 * q + i) * c.N + c.n0 + 4 * nl));
}
__device__ __forceinline__ void copy_finish(const CopyItem& c, const f32x4 (&v)[16], LAS bf16_t* T, int lane) {
    const int nl = lane & 15, q = lane >> 4;
#pragma unroll
    for (int j = 0; j < 4; ++j) {
        u32x4 p0, p1;
        p0.x = cvt_pk_bf16(v[0][j], v[1][j]); p0.y = cvt_pk_bf16(v[2][j], v[3][j]); p0.z = cvt_pk_bf16(v[4][j], v[5][j]); p0.w = cvt_pk_bf16(v[6][j], v[7][j]);
        p1.x = cvt_pk_bf16(v[8][j], v[9][j]); p1.y = cvt_pk_bf16(v[10][j], v[11][j]); p1.z = cvt_pk_bf16(v[12][j], v[13][j]); p1.w = cvt_pk_bf16(v[14][j], v[15][j]);
        LAS u32x4* dst = (LAS u32x4*)(T + (4 * nl + j) * 72 + 16 * q);
        dst[0] = p0; dst[1] = p1;
    }
    asm volatile("s_waitcnt lgkmcnt(0)" ::: "memory");
    const int kc = (lane & 7) * 8;
#pragma unroll
    for (int jj = 0; jj < 8; ++jj) { const int n = (lane >> 3) + 8 * jj; const u32x4 o = *(const LAS u32x4*)(T + n * 72 + kc); *(u32x4*)(c.WT + (size_t)(c.drow0 + n) * c.K + c.k0 + kc) = o; }
    asm volatile("s_waitcnt lgkmcnt(0)" ::: "memory");
}
__device__ __forceinline__ int win_vrow(int n0) {
    if (n0 < 1024 || n0 >= 3072) return n0;
    if (n0 < 2048) { const int q = n0 - 1024; return 1024 + (q >> 7) * 256 + (q & 127); }
    const int q = n0 - 2048; return 1024 + (q >> 7) * 256 + 128 + (q & 127);
}
__device__ __forceinline__ int wfi_vrow(int n0) {
    if (n0 < DFF) return (n0 >> 7) * 256 + (n0 & 127);
    const int q = n0 - DFF; return (q >> 7) * 256 + 128 + (q & 127);
}
constexpr int IT_WIN = (D / 64) * (NIN / 64), IT_WPA = (CD / 64) * (D / 64), IT_WOUT = (D / 64) * (D / 64), IT_WFI = (D / 64) * (NFI / 64), IT_WFO = (DFF / 64) * (D / 64);
constexpr int IT_TOTAL = IT_WIN + 2 * IT_WPA + IT_WOUT + IT_WFI + IT_WFO;
constexpr int SC_ROWS = 144, MOD_ITEMS = NMOD / 64;
constexpr int CW_SCDONE = 192, CW_MODDONE = 256, CW_XQ = 320;
constexpr int MT_STRIDE = 264;

__device__ __forceinline__ CopyItem copy_decode(const Args& a, int it, bf16_t* WIN, bf16_t* WPA, bf16_t* WPB, bf16_t* WOUT, bf16_t* WFI, bf16_t* WFO) {
    CopyItem c;
    if (it < IT_WIN) { const int nb = it % (NIN / 64), kb = it / (NIN / 64); c = CopyItem{a.w_in, WIN, D, NIN, kb * 64, nb * 64, win_vrow(nb * 64)}; return c; } it -= IT_WIN;
    if (it < IT_WPA) { const int nb = it % (D / 64), kb = it / (D / 64); c = CopyItem{a.w_pa, WPA, CD, D, kb * 64, nb * 64, nb * 64}; return c; } it -= IT_WPA;
    if (it < IT_WPA) { const int nb = it % (D / 64), kb = it / (D / 64); c = CopyItem{a.w_pb, WPB, CD, D, kb * 64, nb * 64, nb * 64}; return c; } it -= IT_WPA;
    if (it < IT_WOUT) { const int nb = it % (D / 64), kb = it / (D / 64); c = CopyItem{a.w_out, WOUT, D, D, kb * 64, nb * 64, nb * 64}; return c; } it -= IT_WOUT;
    if (it < IT_WFI) { const int nb = it % (NFI / 64), kb = it / (NFI / 64); c = CopyItem{a.w_ffn_in, WFI, D, NFI, kb * 64, nb * 64, wfi_vrow(nb * 64)}; return c; } it -= IT_WFI;
    { const int nb = it % (D / 64), kb = it / (D / 64); c = CopyItem{a.w_ffn_out, WFO, DFF, D, kb * 64, nb * 64, nb * 64}; return c; }
}

__device__ __forceinline__ void mod_item(const Args& a, const bf16_t* SC, float* MOD, LAS unsigned char* lds, int item, int tid) {
    const int lane = tid & 63, w = __builtin_amdgcn_readfirstlane(tid >> 6), fr = lane & 15, fq = lane >> 4, n0 = item * 64;
    const int c4 = tid & 15, kp = tid >> 4;
    f32x4 acc[2][4];
#pragma unroll
    for (int i = 0; i < 4; ++i) { acc[0][i] = (f32x4){0.f, 0.f, 0.f, 0.f}; acc[1][i] = acc[0][i]; }
    const float* wbase = a.w_ada + n0 + 4 * c4;
    f32x4 wv[8];
#pragma unroll
    for (int j = 0; j < 4; ++j) { const int k = 2 * (kp + 32 * j); wv[2 * j] = __builtin_nontemporal_load((const f32x4*)(wbase + (size_t)k * NMOD)); wv[2 * j + 1] = __builtin_nontemporal_load((const f32x4*)(wbase + (size_t)(k + 1) * NMOD)); }
#pragma unroll 1
    for (int c = 0; c < 8; ++c) {
        LAS bf16_t* T = (LAS bf16_t*)(lds + (c & 1) * (64 * MT_STRIDE * 2));
#pragma unroll
        for (int j = 0; j < 4; ++j) { const int k = 2 * (kp + 32 * j);
#pragma unroll
            for (int i = 0; i < 4; ++i) *(LAS unsigned*)(T + (4 * c4 + i) * MT_STRIDE + k) = cvt_pk_bf16(wv[2 * j][i], wv[2 * j + 1][i]); }
        bf16x8 af[8], af2[8];
#pragma unroll
        for (int ks = 0; ks < 8; ++ks) af[ks] = *(const bf16x8*)(SC + (size_t)(16 * w + fr) * D + c * 256 + ks * 32 + 8 * fq);
        if (w == 0) {
#pragma unroll
            for (int ks = 0; ks < 8; ++ks) af2[ks] = *(const bf16x8*)(SC + (size_t)(128 + fr) * D + c * 256 + ks * 32 + 8 * fq);
        }
        if (c + 1 < 8) {
#pragma unroll
            for (int j = 0; j < 4; ++j) { const int k = (c + 1) * 256 + 2 * (kp + 32 * j); wv[2 * j] = __builtin_nontemporal_load((const f32x4*)(wbase + (size_t)k * NMOD)); wv[2 * j + 1] = __builtin_nontemporal_load((const f32x4*)(wbase + (size_t)(k + 1) * NMOD)); }
        }
        asm volatile("s_waitcnt lgkmcnt(0)" ::: "memory"); __builtin_amdgcn_s_barrier(); asm volatile("" ::: "memory");
#pragma unroll
        for (int ks = 0; ks < 8; ++ks) {
            bf16x8 bfr[4];
#pragma unroll
            for (int nb = 0; nb < 4; ++nb) bfr[nb] = *(const LAS bf16x8*)(T + (16 * nb + fr) * MT_STRIDE + ks * 32 + 8 * fq);
#pragma unroll
            for (int nb = 0; nb < 4; ++nb) acc[0][nb] = __builtin_amdgcn_mfma_f32_16x16x32_bf16(af[ks], bfr[nb], acc[0][nb], 0, 0, 0);
            if (w == 0) {
#pragma unroll
                for (int nb = 0; nb < 4; ++nb) acc[1][nb] = __builtin_amdgcn_mfma_f32_16x16x32_bf16(af2[ks], bfr[nb], acc[1][nb], 0, 0, 0);
            }
        }
    }
#pragma unroll
    for (int nb = 0; nb < 4; ++nb) { const float bias = a.b_ada[n0 + 16 * nb + fr];
#pragma unroll
        for (int e = 0; e < 4; ++e) {
            __hip_atomic_store(MOD + (size_t)(16 * w + 4 * fq + e) * NMOD + n0 + 16 * nb + fr, acc[0][nb][e] + bias, __ATOMIC_RELAXED, __HIP_MEMORY_SCOPE_AGENT);
            if (w == 0 && 128 + 4 * fq + e < MODROWS) __hip_atomic_store(MOD + (size_t)(128 + 4 * fq + e) * NMOD + n0 + 16 * nb + fr, acc[1][nb][e] + bias, __ATOMIC_RELAXED, __HIP_MEMORY_SCOPE_AGENT);
        } }
    asm volatile("s_waitcnt vmcnt(0) lgkmcnt(0)" ::: "memory");
    __syncthreads();
}

__device__ __forceinline__ void row_load(f32x4 (&v)[8], const float* row, int lane) {
#pragma unroll
    for (int j = 0; j < 8; ++j) v[j] = *(const f32x4*)(row + 4 * lane + 256 * j);
}
__device__ __forceinline__ void row_load_nt(f32x4 (&v)[8], const float* row, int lane) {
#pragma unroll
    for (int j = 0; j < 8; ++j) v[j] = __builtin_nontemporal_load((const f32x4*)(row + 4 * lane + 256 * j));
}
__device__ __forceinline__ void row_load_bf16(f32x4 (&v)[8], const bf16_t* row, int lane) {
#pragma unroll
    for (int j = 0; j < 8; ++j) { const u32x2 p = __builtin_nontemporal_load((const u32x2*)(row + 4 * lane + 256 * j)); v[j] = (f32x4){bf_lo(p.x), bf_hi(p.x), bf_lo(p.y), bf_hi(p.y)}; }
}
__device__ __forceinline__ void norm_core_bf16(const f32x4 (&v)[8], const f32x4 (&g)[8], const float* sc, const float* sh, bf16_t* orow, int lane) {
    float s = 0.f;
#pragma unroll
    for (int j = 0; j < 8; ++j) s += (v[j][0] * v[j][0] + v[j][1] * v[j][1]) + (v[j][2] * v[j][2] + v[j][3] * v[j][3]);
    const float rstd = rsqrtf(wave_sum(s) * (1.0f / D) + EPS);
#pragma unroll
    for (int j = 0; j < 8; ++j) { const int c = 4 * lane + 256 * j; const f32x4 a = *(const f32x4*)(sc + c), b = *(const f32x4*)(sh + c);
        const f32x4 o = (v[j] * rstd) * g[j] * (1.0f + a) + b; u32x2 wv; wv.x = cvt_pk_bf16(o[0], o[1]); wv.y = cvt_pk_bf16(o[2], o[3]); *(u32x2*)(orow + c) = wv; }
}
constexpr int TS = 136;
__device__ __forceinline__ void mixer_prompt_pair(const Args& a, LAS unsigned char* lds, int item, int tid, const bf16_t* U, const bf16_t* V, bf16_t* YB, const float* VSS) {
    const int lane = tid & 63, w = tid >> 6, fr = lane & 15, fq = lane >> 4, half = w >> 2, hw = w & 3, htid = tid & 255;
    const int g = item & 7, ch = 2 * ((item >> 3) & 7) + half, b = item >> 6;
    const int m0 = b * SEQ + ch * 128;
    LAS bf16_t* Wc = (LAS bf16_t*)lds; LAS bf16_t* VT = (LAS bf16_t*)(lds + (1 + half) * 128 * TS * 2); LAS float* rs = (LAS float*)(lds + 3 * 128 * TS * 2) + half * 128;
    if (htid < 128) rs[htid] = rsqrtf(VSS[m0 + htid] * (1.0f / CD) + EPS);
    for (int i = tid; i < 128 * 32; i += NTHREADS) { const int t = i >> 5, s4 = (i & 31) * 4; f32x4 wv = *(const f32x4*)(a.w_sg + ((size_t)g * 128 + t) * 128 + s4);
#pragma unroll
        for (int j = 0; j < 4; ++j) if (s4 + j > t) wv[j] = 0.f;
        u32x2 o; o.x = cvt_pk_bf16(wv[0], wv[1]); o.y = cvt_pk_bf16(wv[2], wv[3]); *(LAS u32x2*)(Wc + t * TS + s4) = o; }
    __syncthreads();
#pragma unroll
    for (int it = 0; it < 8; ++it) { const int s = htid & 127, cg = (htid >> 7) + 2 * it, c0 = g * 128 + cg * 8;
        const u32x4 p = *(const u32x4*)(V + (size_t)(m0 + s) * CD + c0); const float r = rs[s];
        const f32x4 g0 = *(const f32x4*)(a.g_v + c0), g1 = *(const f32x4*)(a.g_v + c0 + 4);
        float vn[8] = {bf_lo(p.x) * r * g0[0], bf_hi(p.x) * r * g0[1], bf_lo(p.y) * r * g0[2], bf_hi(p.y) * r * g0[3], bf_lo(p.z) * r * g1[0], bf_hi(p.z) * r * g1[1], bf_lo(p.w) * r * g1[2], bf_hi(p.w) * r * g1[3]};
        if (ch == 15) { float* o = a.out + O_SGVP + ((size_t)(b * 128 + s) * 8 + g) * 128 + cg * 8; *(f32x4*)o = (f32x4){vn[0], vn[1], vn[2], vn[3]}; *(f32x4*)(o + 4) = (f32x4){vn[4], vn[5], vn[6], vn[7]}; }
#pragma unroll
        for (int j = 0; j < 8; j += 2) { const unsigned pk = cvt_pk_bf16(vn[j], vn[j + 1]); VT[(cg * 8 + j) * TS + s] = (bf16_t)(pk & 0xffffu); VT[(cg * 8 + j + 1) * TS + s] = (bf16_t)(pk >> 16); } }
    __syncthreads();
    const int wr = hw >> 1, wc = hw & 1;
    f32x4 acc[4][4];
#pragma unroll
    for (int m = 0; m < 4; ++m)
#pragma unroll
        for (int n = 0; n < 4; ++n) acc[m][n] = (f32x4){0.f, 0.f, 0.f, 0.f};
#pragma unroll
    for (int ks = 0; ks < 4; ++ks) {
        bf16x8 bf[4];
#pragma unroll
        for (int n = 0; n < 4; ++n) bf[n] = *(const LAS bf16x8*)(VT + (wc * 64 + n * 16 + fr) * TS + ks * 32 + fq * 8);
#pragma unroll
        for (int m = 0; m < 4; ++m) { const bf16x8 af = *(const LAS bf16x8*)(Wc + (wr * 64 + m * 16 + fr) * TS + ks * 32 + fq * 8);
#pragma unroll
            for (int n = 0; n < 4; ++n) acc[m][n] = __builtin_amdgcn_mfma_f32_16x16x32_bf16(bf[n], af, acc[m][n], 0, 0, 0); }
    }
#pragma unroll
    for (int m = 0; m < 4; ++m) { const int t = wr * 64 + m * 16 + fr; const float bias = a.b_sg[g * 128 + t]; u32x2 up[4];
#pragma unroll
        for (int n = 0; n < 4; ++n) up[n] = *(const u32x2*)(U + (size_t)(m0 + t) * CD + g * 128 + wc * 64 + n * 16 + 4 * fq);
#pragma unroll
        for (int n = 0; n < 4; ++n) { const size_t off = (size_t)(m0 + t) * CD + g * 128 + wc * 64 + n * 16 + 4 * fq;
            u32x2 o; o.x = cvt_pk_bf16(bf_lo(up[n].x) * (acc[m][n][0] + bias), bf_hi(up[n].x) * (acc[m][n][1] + bias)); o.y = cvt_pk_bf16(bf_lo(up[n].y) * (acc[m][n][2] + bias), bf_hi(up[n].y) * (acc[m][n][3] + bias));
            *(u32x2*)(YB + off) = o; } }
    __syncthreads();
}
__device__ __forceinline__ void mixer_sample_item(const Args& a, LAS unsigned char* lds, int bs, int tid, const bf16_t* U, const bf16_t* V, bf16_t* YB, const float* VSS) {
    const int lane = tid & 63, w = tid >> 6; const int m0 = MP + bs * DSEQ;
    LAS float* rs = (LAS float*)lds;
    if (tid < 4) rs[tid] = rsqrtf(VSS[m0 + tid] * (1.0f / CD) + EPS);
    __syncthreads();
    const int c = 2 * tid, g = c >> 7;
    float vn[4][2];
#pragma unroll
    for (int s = 0; s < 4; ++s) { const unsigned p = *(const unsigned*)(V + (size_t)(m0 + s) * CD + c); const float r = rs[s]; vn[s][0] = bf_lo(p) * r * a.g_v[c]; vn[s][1] = bf_hi(p) * r * a.g_v[c + 1];
        float* o = a.out + O_SGVS + (size_t)(bs * DSEQ + s) * CD + c; o[0] = vn[s][0]; o[1] = vn[s][1]; }
#pragma unroll
    for (int t = 0; t < 4; ++t) { float s0 = a.b_sg[g * 128 + t], s1 = s0;
#pragma unroll
        for (int s = 0; s <= t; ++s) { const float wv = a.w_sg[((size_t)g * 128 + t) * 128 + s]; s0 += wv * vn[s][0]; s1 += wv * vn[s][1]; }
        const unsigned up = *(const unsigned*)(U + (size_t)(m0 + t) * CD + c);
        *(unsigned*)(YB + (size_t)(m0 + t) * CD + c) = cvt_pk_bf16(bf_lo(up) * s0, bf_hi(up) * s1); }
    __syncthreads();
}

__global__ void __launch_bounds__(NTHREADS, 2) fwd_megakernel(Args a) {
    extern __shared__ __attribute__((aligned(16))) unsigned char lds_raw[];
    LAS unsigned char* lds = (LAS unsigned char*)lds_raw;
    const int tid = threadIdx.x, lane = tid & 63, wave = __builtin_amdgcn_readfirstlane(tid >> 6);
    const int G = gridDim.x, bx = blockIdx.x;
    const int gw = bx * 8 + wave, NGW = G * 8;
    unsigned char* ws = a.ws;
    unsigned* ctl = (unsigned*)(ws + WS_CTL);
    float* MOD = (float*)(ws + WS_MOD);
    bf16_t *WIN = (bf16_t*)(ws + WS_WIN), *WPA = (bf16_t*)(ws + WS_WPA), *WPB = (bf16_t*)(ws + WS_WPB), *WOUT = (bf16_t*)(ws + WS_WOUT), *WFI = (bf16_t*)(ws + WS_WFI), *WFO = (bf16_t*)(ws + WS_WFO);
    bf16_t *H = (bf16_t*)(ws + WS_H), *MRG = (bf16_t*)(ws + WS_MRG), *BG = (bf16_t*)(ws + WS_BG), *Z = (bf16_t*)(ws + WS_Z), *U = (bf16_t*)(ws + WS_U), *V = (bf16_t*)(ws + WS_V);
    bf16_t *GA = (bf16_t*)(ws + WS_GA), *GB = (bf16_t*)(ws + WS_GB), *YA = (bf16_t*)(ws + WS_YA), *YB = (bf16_t*)(ws + WS_YB), *ACT = (bf16_t*)(ws + WS_ACT);
    float* X = a.out + O_Y;
    bf16_t* PART5 = (bf16_t*)(ws + WS_ACT + (size_t)M * DFF * 2);
    bf16_t* PART8 = (bf16_t*)(ws + WS_H);
    bf16_t* XB = (bf16_t*)(ws + WS_ACT + (size_t)M * DFF * 2 + (size_t)P5_SPLIT * MS * D * 4);
    bf16_t* SCB = MRG;
    const int lo = a.ph_lo, hi = a.ph_hi;
    volatile LAS unsigned* MISC = (volatile LAS unsigned*)(lds + 131072 + 320);
    if (tid < 32) MISC[tid] = 0u;
    __syncthreads();
    XcdBarrier xbar = xcd_barrier_post(ctl + CW_BAR + XCD_BAR_WORDS * a.li, MISC + 8);
    if (lo < 0) cg::this_grid().sync();
#ifdef ONLY_PHASE
#define IN(k) ((k) == ONLY_PHASE)
#else
#define IN(k) (lo <= (k) && (k) < hi)
#endif
#define SEAM(k) do { if (IN(k) && IN((k) + 1)) { xcd_barrier(xbar); } } while (0)

    if (IN(0)) {
        unsigned* q = ctl + 1024 * a.li;
        if (gw < SC_ROWS) {
            const int it = gw;
            const float* cr = it < NBP ? a.c_prompt + (size_t)it * D : a.c_sample + (size_t)(it - NBP) * D;
#pragma unroll
            for (int j = 0; j < 8; ++j) { const int c = 4 * lane + 256 * j; f32x4 v = (f32x4){0.f, 0.f, 0.f, 0.f}; if (it < MODROWS) v = *(const f32x4*)(cr + c);
                const unsigned long long o = (unsigned long long)cvt_pk_bf16(siluf_(v[0]), siluf_(v[1])) | ((unsigned long long)cvt_pk_bf16(siluf_(v[2]), siluf_(v[3])) << 32);
                __hip_atomic_store((unsigned long long*)(SCB + (size_t)it * D + c), o, __ATOMIC_RELAXED, __HIP_MEMORY_SCOPE_AGENT); }
            asm volatile("s_waitcnt vmcnt(0)" ::: "memory");
            __hip_atomic_fetch_add(q + CW_SCDONE, 1u, __ATOMIC_RELAXED, __HIP_MEMORY_SCOPE_AGENT);
        }
        {
            LAS bf16_t* Te = (LAS bf16_t*)(lds + wave * 16384); constexpr int QNe = IT_TOTAL / 8;
            const int xq = (int)(xb_xcc_id() & 7u); unsigned* qc = q + CW_XQ + 64 * xq;
            int cv = 0; if (lane == 0) cv = (int)atomicAdd(qc, 2u);
            const int c = __builtin_amdgcn_readfirstlane(cv);
            if (c < QNe) { const CopyItem c0 = copy_decode(a, xq * QNe + c, WIN, WPA, WPB, WOUT, WFI, WFO), c1 = copy_decode(a, xq * QNe + c + 1, WIN, WPA, WPB, WOUT, WFI, WFO);
                f32x4 v0[16], v1[16]; copy_load(c0, v0, lane); copy_load(c1, v1, lane); copy_finish(c0, v0, Te, lane); copy_finish(c1, v1, Te, lane); }
        }
        {
            if (lane == 0) { unsigned sp = 0; while (__hip_atomic_load(q + CW_SCDONE, __ATOMIC_RELAXED, __HIP_MEMORY_SCOPE_AGENT) < (unsigned)SC_ROWS * 64u && ++sp < (1u << 22)) __builtin_amdgcn_s_sleep(1); }
            asm volatile("s_waitcnt vmcnt(0)" ::: "memory");
            __syncthreads();
            for (int it0 = bx; it0 < MOD_ITEMS + 64; it0 += G) {
                const int xg = it0 & 7, idx = it0 >> 3; if (idx >= MOD_ITEMS / 8) break; const int it = xg * (MOD_ITEMS / 8) + idx;
                mod_item(a, SCB, MOD, lds, it, tid);
                if (tid == 0) __hip_atomic_fetch_add(q + CW_MODDONE, 1u, __ATOMIC_RELAXED, __HIP_MEMORY_SCOPE_AGENT);
                __syncthreads();
            }
        }
        LAS bf16_t* T = (LAS bf16_t*)(lds + wave * 16384);
        {
            constexpr int QN = IT_TOTAL / 8;
            static_assert(IT_TOTAL % 16 == 0, "queue split");
            const int x0 = (int)(xb_xcc_id() & 7u);
            for (int qi = 0; qi < 8; ++qi) {
                const int xq = (x0 + qi) & 7; unsigned* qc = q + CW_XQ + 64 * xq;
                if ((int)__builtin_amdgcn_readfirstlane(__hip_atomic_load(qc, __ATOMIC_RELAXED, __HIP_MEMORY_SCOPE_AGENT)) >= QN) continue;
                int cv = 0; if (lane == 0) cv = (int)atomicAdd(qc, 2u);
                for (;;) {
                    const int c = __builtin_amdgcn_readfirstlane(cv);
                    if (c >= QN) break;
                    const CopyItem c0 = copy_decode(a, xq * QN + c, WIN, WPA, WPB, WOUT, WFI, WFO), c1 = copy_decode(a, xq * QN + c + 1, WIN, WPA, WPB, WOUT, WFI, WFO);
                    f32x4 v0[16], v1[16];
                    copy_load(c0, v0, lane); copy_load(c1, v1, lane);
                    cv = 0; if (lane == 0) cv = (int)atomicAdd(qc, 2u);
                    copy_finish(c0, v0, T, lane); copy_finish(c1, v1, T, lane);
                }
            }
        }
        {
            if (lane == 0) { unsigned sp = 0; while (__hip_atomic_load(q + CW_MODDONE, __ATOMIC_RELAXED, __HIP_MEMORY_SCOPE_AGENT) < (unsigned)MOD_ITEMS && ++sp < (1u << 22)) __builtin_amdgcn_s_sleep(1); }
            asm volatile("s_waitcnt vmcnt(0)" ::: "memory");
            f32x4 gv[8], v[8]; row_load(gv, a.g_mix, lane);
            if (gw < M) row_load_nt(v, gw < MP ? a.x_prompt + (size_t)gw * D : a.x_sample + (size_t)(gw - MP) * D, lane);
            for (int m = gw; m < M; m += NGW) { const int m2 = m + NGW; f32x4 nv[8];
                if (m2 < M) row_load_nt(nv, m2 < MP ? a.x_prompt + (size_t)m2 * D : a.x_sample + (size_t)(m2 - MP) * D, lane);
                const float* mr = MOD + (size_t)mod_row(m) * NMOD;
                norm_core_bf16(v, gv, mr + 1 * D, mr + 0 * D, H + (size_t)m * D, lane);
#pragma unroll
                for (int j = 0; j < 8; ++j) v[j] = nv[j]; }
        }
    }
    SEAM(1);
    if (IN(2)) {
        pg8::SchedPlain S; S.o.init(M / 256, NIN / 256, G, bx); S.A = (const char*)H; S.B = (const char*)WIN; S.tsA = (size_t)256 * D * 2; S.tsB = (size_t)256 * D * 2; S.nk = D / 64;
        pg8::EpiIn E{BG, Z, U, V, GA, GB, (float*)(ctl + CW_VSS)};
        pg8::gemm_phase(lds, D, D, S, E);
    }
    SEAM(2);
    if (IN(3)) {
        for (int it = bx; it < 256 + NBS; it += G) { if (it < 256) mixer_prompt_pair(a, lds, it, tid, U, V, YB, (const float*)(ctl + CW_VSS)); else mixer_sample_item(a, lds, it - 256, tid, U, V, YB, (const float*)(ctl + CW_VSS)); }
        for (int it = gw; it < (MP / 8) * 2; it += NGW) {
            const int r0 = (it >> 1) * 8, c = (it & 1) * 512 + lane * 8, t0 = r0 & (SEQ - 1);
            u32x4 zr[10], bgr[8];
#pragma unroll
            for (int i = 0; i < 10; ++i) { zr[i] = (u32x4){0u, 0u, 0u, 0u}; if (i >= 2 || t0 > 0) zr[i] = __builtin_nontemporal_load((const u32x4*)(Z + (size_t)(r0 - 2 + i) * CD + c)); }
#pragma unroll
            for (int i = 0; i < 8; ++i) bgr[i] = __builtin_nontemporal_load((const u32x4*)(BG + (size_t)(r0 + i) * CD + c));
            float wk[3][8];
#pragma unroll
            for (int k = 0; k < 3; ++k) { const f32x4 w0 = *(const f32x4*)(a.w_conv + k * CD + c), w1 = *(const f32x4*)(a.w_conv + k * CD + c + 4);
#pragma unroll
                for (int j = 0; j < 4; ++j) { wk[k][j] = w0[j]; wk[k][4 + j] = w1[j]; } }
#pragma unroll
            for (int i = 0; i < 8; ++i) {
                float y[8], zc[8];
#pragma unroll
                for (int j = 0; j < 4; ++j) {
                    const float z0l = bf_lo(zr[i][j]), z0h = bf_hi(zr[i][j]), z1l = bf_lo(zr[i + 1][j]), z1h = bf_hi(zr[i + 1][j]), z2l = bf_lo(zr[i + 2][j]), z2h = bf_hi(zr[i + 2][j]);
                    y[2 * j] = bf_lo(bgr[i][j]) * (wk[0][2 * j] * z0l + wk[1][2 * j] * z1l + wk[2][2 * j] * z2l);
                    y[2 * j + 1] = bf_hi(bgr[i][j]) * (wk[0][2 * j + 1] * z0h + wk[1][2 * j + 1] * z1h + wk[2][2 * j + 1] * z2h);
                    zc[2 * j] = z2l; zc[2 * j + 1] = z2h; }
                u32x4 o; o.x = cvt_pk_bf16(y[0], y[1]); o.y = cvt_pk_bf16(y[2], y[3]); o.z = cvt_pk_bf16(y[4], y[5]); o.w = cvt_pk_bf16(y[6], y[7]);
                *(u32x4*)(YA + (size_t)(r0 + i) * CD + c) = o;
                if (t0 + i >= SEQ - 2) { float* dst = a.out + O_CONVP + ((size_t)(r0 >> 11) * 2 + (t0 + i - (SEQ - 2))) * CD + c;
                    *(f32x4*)dst = (f32x4){zc[0], zc[1], zc[2], zc[3]}; *(f32x4*)(dst + 4) = (f32x4){zc[4], zc[5], zc[6], zc[7]}; }
            }
        }
        for (int idx = MP * 128 + bx * NTHREADS + tid; idx < M * 128; idx += G * NTHREADS) {
            const int r = idx >> 7, c = (idx & 127) * 8;
            int t, S_; const float* pre = nullptr;
            if (r < MP) { t = r & (SEQ - 1); S_ = SEQ; } else { t = (r - MP) & 3; S_ = DSEQ; pre = a.state_conv + (size_t)((r - MP) >> 2) * 2 * CD + c; }
            float z2[8], z1[8], z0[8];
            { const u32x4 p = *(const u32x4*)(Z + (size_t)r * CD + c); z2[0] = bf_lo(p.x); z2[1] = bf_hi(p.x); z2[2] = bf_lo(p.y); z2[3] = bf_hi(p.y); z2[4] = bf_lo(p.z); z2[5] = bf_hi(p.z); z2[6] = bf_lo(p.w); z2[7] = bf_hi(p.w); }
            if (t >= 1) { const u32x4 p = *(const u32x4*)(Z + (size_t)(r - 1) * CD + c); z1[0] = bf_lo(p.x); z1[1] = bf_hi(p.x); z1[2] = bf_lo(p.y); z1[3] = bf_hi(p.y); z1[4] = bf_lo(p.z); z1[5] = bf_hi(p.z); z1[6] = bf_lo(p.w); z1[7] = bf_hi(p.w); }
            else {
#pragma unroll
                for (int j = 0; j < 8; ++j) z1[j] = pre ? pre[CD + j] : 0.f; }
            if (t >= 2) { const u32x4 p = *(const u32x4*)(Z + (size_t)(r - 2) * CD + c); z0[0] = bf_lo(p.x); z0[1] = bf_hi(p.x); z0[2] = bf_lo(p.y); z0[3] = bf_hi(p.y); z0[4] = bf_lo(p.z); z0[5] = bf_hi(p.z); z0[6] = bf_lo(p.w); z0[7] = bf_hi(p.w); }
            else {
#pragma unroll
                for (int j = 0; j < 8; ++j) z0[j] = pre ? pre[t * CD + j] : 0.f; }
            const u32x4 bgp = *(const u32x4*)(BG + (size_t)r * CD + c);
            const float bg[8] = {bf_lo(bgp.x), bf_hi(bgp.x), bf_lo(bgp.y), bf_hi(bgp.y), bf_lo(bgp.z), bf_hi(bgp.z), bf_lo(bgp.w), bf_hi(bgp.w)};
            float y[8];
#pragma unroll
            for (int j = 0; j < 8; ++j) y[j] = bg[j] * (a.w_conv[c + j] * z0[j] + a.w_conv[CD + c + j] * z1[j] + a.w_conv[2 * CD + c + j] * z2[j]);
            u32x4 o; o.x = cvt_pk_bf16(y[0], y[1]); o.y = cvt_pk_bf16(y[2], y[3]); o.z = cvt_pk_bf16(y[4], y[5]); o.w = cvt_pk_bf16(y[6], y[7]);
            *(u32x4*)(YA + (size_t)r * CD + c) = o;
            if (t >= S_ - 2) {
                float* dst = (r < MP) ? a.out + O_CONVP + ((size_t)(r >> 11) * 2 + (t - (S_ - 2))) * CD + c : a.out + O_CONVS + ((size_t)((r - MP) >> 2) * 2 + (t - (S_ - 2))) * CD + c;
                *(f32x4*)dst = (f32x4){z2[0], z2[1], z2[2], z2[3]}; *(f32x4*)(dst + 4) = (f32x4){z2[4], z2[5], z2[6], z2[7]};
            }
        }
    }
    SEAM(3);
    if (IN(4)) {
        pg8::SchedDual S; S.o.init(M / 256, D / 256, G, bx); S.A0 = (const char*)YA; S.B0 = (const char*)WPA; S.A1 = (const char*)YB; S.B1 = (const char*)WPB; S.tsA = (size_t)256 * CD * 2; S.tsB = (size_t)256 * CD * 2; S.nk = CD / 64;
        pg8::EpiMerge E{GA, GB, MRG};
        pg8::gemm_phase(lds, CD, CD, S, E);
    }
    SEAM(4);
    if (IN(5)) {
        pg8::SchedSplit S; S.init(D / 256, P5_SPLIT, (D / 128) / P5_SPLIT, D / 64, G, bx); S.A = (const char*)MRG; S.B = (const char*)WOUT; S.tsA = (size_t)256 * D * 2; S.tsB = (size_t)256 * D * 2;
        pg8::EpiResidSplit<false> E{a.x_prompt, XB, PART5, MOD + 2 * D};
        pg8::gemm_phase(lds, D, D, S, E);
    }
    SEAM(5);
    if (IN(6)) {
        f32x4 gv[8], v[8]; row_load(gv, a.g_ffn, lane);
        const int rstep = NGW > MS ? NGW - MS : NGW; int m = (NGW > MS) ? (gw < MS ? MP + gw : gw - MS) : gw;
        if (m < M) { if (m < MP) row_load_bf16(v, XB + (size_t)m * D, lane); else row_load(v, a.x_sample + (size_t)(m - MP) * D, lane); }
        while (m < M) { int m2 = (NGW > MS) ? (m >= MP ? M : m + rstep) : m + rstep; if (NGW > MS && m2 >= MP) m2 = M; f32x4 nv[8];
            if (m2 < M) { if (m2 < MP) row_load_bf16(nv, XB + (size_t)m2 * D, lane); else row_load(nv, a.x_sample + (size_t)(m2 - MP) * D, lane); }
            if (m >= MP) {
#pragma unroll 4
                for (int q = 0; q < P5_SPLIT; ++q) {
#pragma unroll
                    for (int j = 0; j < 8; ++j) { const u32x2 p = __builtin_nontemporal_load((const u32x2*)(PART5 + ((size_t)q * MS + (m - MP)) * D + 4 * lane + 256 * j)); v[j] += (f32x4){bf_lo(p.x), bf_hi(p.x), bf_lo(p.y), bf_hi(p.y)}; } }
#pragma unroll
                for (int j = 0; j < 8; ++j) { u32x2 o; o.x = cvt_pk_bf16(v[j][0], v[j][1]); o.y = cvt_pk_bf16(v[j][2], v[j][3]); *(u32x2*)(XB + (size_t)m * D + 4 * lane + 256 * j) = o; } }
            const float* mr = MOD + (size_t)mod_row(m) * NMOD;
            norm_core_bf16(v, gv, mr + 4 * D, mr + 3 * D, H + (size_t)m * D, lane);
#pragma unroll
            for (int j = 0; j < 8; ++j) v[j] = nv[j];
            m = m2; }
    }
    SEAM(6);
    if (IN(7)) {
        pg8::SchedPlain S; S.o.init(M / 256, NFI / 256, G, bx); S.A = (const char*)H; S.B = (const char*)WFI; S.tsA = (size_t)256 * D * 2; S.tsB = (size_t)256 * D * 2; S.nk = D / 64;
        pg8::EpiSwiglu E{ACT};
        pg8::gemm_phase(lds, D, D, S, E);
    }
    SEAM(7);
    if (IN(8)) {
        pg8::SchedSplit S; S.init(D / 256, P8_SPLIT, (DFF / 128) / P8_SPLIT, DFF / 64, G, bx); S.A = (const char*)ACT; S.B = (const char*)WFO; S.tsA = (size_t)256 * DFF * 2; S.tsB = (size_t)256 * DFF * 2;
        pg8::EpiResidSplit<true> E{XB, XB, PART8, MOD + 5 * D};
        pg8::gemm_phase(lds, DFF, DFF, S, E);
    }
    SEAM(8);
    if (IN(9)) {
        f32x4 gv[8], v[8]; row_load(gv, a.g_final, lane);
        const int rstep = NGW > MS ? NGW - MS : NGW; int m = (NGW > MS) ? (gw < MS ? MP + gw : gw - MS) : gw;
        if (m < M) row_load_bf16(v, XB + (size_t)m * D, lane);
        while (m < M) { float* xr = X + (size_t)m * D; int m2 = (NGW > MS) ? (m >= MP ? M : m + rstep) : m + rstep; if (NGW > MS && m2 >= MP) m2 = M; f32x4 nv[8];
            if (m2 < M) row_load_bf16(nv, XB + (size_t)m2 * D, lane);
            if (m >= MP) {
#pragma unroll 4
                for (int q = 0; q < P8_SPLIT; ++q) {
#pragma unroll
                    for (int j = 0; j < 8; ++j) { const u32x2 p = __builtin_nontemporal_load((const u32x2*)(PART8 + ((size_t)q * MS + (m - MP)) * D + 4 * lane + 256 * j)); v[j] += (f32x4){bf_lo(p.x), bf_hi(p.x), bf_lo(p.y), bf_hi(p.y)}; } } }
            float s = 0.f;
#pragma unroll
            for (int j = 0; j < 8; ++j) s += (v[j][0] * v[j][0] + v[j][1] * v[j][1]) + (v[j][2] * v[j][2] + v[j][3] * v[j][3]);
            const float rstd = rsqrtf(wave_sum(s) * (1.0f / D) + EPS);
#pragma unroll
            for (int j = 0; j < 8; ++j) { const int c = 4 * lane + 256 * j; __builtin_nontemporal_store((v[j] * rstd) * gv[j], (f32x4*)(xr + c)); }
#pragma unroll
            for (int j = 0; j < 8; ++j) v[j] = nv[j];
            m = m2; }
    }
#undef IN
#undef SEAM
}

extern "C" void kernel_launch(void* const* d_in, const int* in_sizes, int n_in, void* d_out, int out_size, void* d_ws, size_t ws_size, hipStream_t stream) {
    static int grid = 0;
    if (grid == 0) {
        if (n_in != 20 || ws_size < WS_END) { fprintf(stderr, "kernel_launch: need 20 inputs and >= %zu bytes of workspace; got %d, %zu\n", (size_t)WS_END, n_in, ws_size); grid = -1; return; }
        int dev = 0, cus = 0, per_cu = 0;
        if (hipGetDevice(&dev) != hipSuccess || hipDeviceGetAttribute(&cus, hipDeviceAttributeMultiprocessorCount, dev) != hipSuccess) { grid = -1; return; }
        if (hipFuncSetAttribute((const void*)fwd_megakernel, hipFuncAttributeMaxDynamicSharedMemorySize, LDS_BYTES) != hipSuccess) { fprintf(stderr, "kernel_launch: hipFuncSetAttribute failed\n"); grid = -1; return; }
        if (hipOccupancyMaxActiveBlocksPerMultiprocessor(&per_cu, (const void*)fwd_megakernel, NTHREADS, LDS_BYTES) != hipSuccess || per_cu < 1) { fprintf(stderr, "kernel_launch: occupancy query reports %d blocks per CU\n", per_cu); grid = -1; return; }
        grid = cus * 1;
    }
    if (grid < 0) return;
    hipMemsetAsync((char*)d_ws + WS_CTL, 0, CTL_BYTES, stream);
    Args a{};
    a.x_prompt = (const float*)d_in[0]; a.x_sample = (const float*)d_in[1]; a.state_conv = (const float*)d_in[2]; a.c_prompt = (const float*)d_in[3]; a.c_sample = (const float*)d_in[4];
    a.g_mix = (const float*)d_in[5]; a.g_ffn = (const float*)d_in[6]; a.w_ada = (const float*)d_in[7]; a.b_ada = (const float*)d_in[8]; a.w_in = (const float*)d_in[9]; a.w_conv = (const float*)d_in[10];
    a.g_v = (const float*)d_in[11]; a.w_sg = (const float*)d_in[12]; a.b_sg = (const float*)d_in[13]; a.w_pa = (const float*)d_in[14]; a.w_pb = (const float*)d_in[15]; a.w_out = (const float*)d_in[16];
    a.w_ffn_in = (const float*)d_in[17]; a.w_ffn_out = (const float*)d_in[18]; a.g_final = (const float*)d_in[19];
    a.out = (float*)d_out; a.ws = (unsigned char*)d_ws;
#if MK_N_LAUNCHES == 1
    if (PROBE_PHASE < 0) {
        a.ph_lo = 0; a.ph_hi = NPHASE; a.li = 0;
        void* args[] = {&a};
        hipError_t e = hipLaunchCooperativeKernel((const void*)fwd_megakernel, dim3(grid), dim3(NTHREADS), args, LDS_BYTES, stream);
        if (e != hipSuccess) fprintf(stderr, "kernel_launch: cooperative launch failed: %s (grid %d)\n", hipGetErrorString(e), grid);
    } else {
        const int cuts[4] = {0, PROBE_PHASE + 1, PROBE_PHASE + 1, NPHASE};
        for (int li = 0; li < 3; ++li) { a.ph_lo = (li == 1) ? PROBE_PHASE : cuts[li]; a.ph_hi = cuts[li + 1]; a.li = li; if (a.ph_lo >= a.ph_hi) continue;
            void* args[] = {&a};
            hipError_t e = hipLaunchCooperativeKernel((const void*)fwd_megakernel, dim3(grid), dim3(NTHREADS), args, LDS_BYTES, stream);
            if (e != hipSuccess) fprintf(stderr, "kernel_launch: cooperative launch failed: %s (grid %d)\n", hipGetErrorString(e), grid); }
    }
#else
    for (int p = 0; p < NPHASE; ++p) { a.ph_lo = p; a.ph_hi = p + 1; a.li = 0; hipLaunchKernelGGL(fwd_megakernel, dim3(grid), dim3(NTHREADS), LDS_BYTES, stream, a); }
#endif
}
```

```cpp
#include <hip/hip_runtime.h>
#include <hip/hip_cooperative_groups.h>
#include <cstdio>
#include <cstdint>
namespace cg = cooperative_groups;

#define LAS __attribute__((address_space(3)))
typedef unsigned short bf16_t;
typedef short bf16x8 __attribute__((ext_vector_type(8)));
typedef float f32x4 __attribute__((ext_vector_type(4)));
typedef unsigned u32x4 __attribute__((ext_vector_type(4)));
typedef unsigned u32x2 __attribute__((ext_vector_type(2)));

#define PROBE_PHASE -1
#ifndef MK_N_LAUNCHES
#define MK_N_LAUNCHES 1
#endif

constexpr int D = 2048, MP = 8192, MS = 512, M = MP + MS, SEQ = 2048, NBP = 4, NBS = 128, DSEQ = 4;
constexpr int CD = 1024, NIN = 9216, DFF = 5632, NFI = 2 * DFF, NMOD = 6 * D, MODROWS = NBP + NBS;
constexpr float EPS = 1e-6f;
constexpr int NPHASE = 10;
constexpr int P5_SPLIT = 8, P8_SPLIT = 11;
constexpr size_t O_Y = 0, O_CONVP = (size_t)M * D, O_CONVS = O_CONVP + (size_t)NBP * 2 * CD, O_SGVP = O_CONVS + (size_t)NBS * 2 * CD, O_SGVS = O_SGVP + (size_t)NBP * 128 * 1024;
constexpr size_t al4k(size_t x) { return (x + 4095) & ~(size_t)4095; }
constexpr size_t WS_CTL = 0, CTL_BYTES = 131072;
constexpr size_t WS_MOD = 131072;
constexpr int CW_BAR = 4096, CW_VSS = 16384;
constexpr size_t WS_WIN = al4k(WS_MOD + (size_t)MODROWS * NMOD * 4);
constexpr size_t WS_WPA = al4k(WS_WIN + (size_t)NIN * D * 2);
constexpr size_t WS_WPB = al4k(WS_WPA + (size_t)D * CD * 2);
constexpr size_t WS_WOUT = al4k(WS_WPB + (size_t)D * CD * 2);
constexpr size_t WS_WFI = al4k(WS_WOUT + (size_t)D * D * 2);
constexpr size_t WS_WFO = al4k(WS_WFI + (size_t)NFI * D * 2);
constexpr size_t WS_H = al4k(WS_WFO + (size_t)D * DFF * 2);
constexpr size_t WS_MRG = al4k(WS_H + (size_t)M * D * 2);
constexpr size_t WS_R1 = al4k(WS_MRG + (size_t)M * D * 2);
constexpr size_t WS_BG = WS_R1;
constexpr size_t WS_Z = WS_BG + (size_t)M * CD * 2;
constexpr size_t WS_U = WS_Z + (size_t)M * CD * 2;
constexpr size_t WS_V = WS_U + (size_t)M * CD * 2;
constexpr size_t WS_GA = WS_V + (size_t)M * CD * 2;
constexpr size_t WS_GB = WS_GA + (size_t)M * D * 2;
constexpr size_t WS_YA = WS_GB + (size_t)M * D * 2;
constexpr size_t WS_YB = WS_YA + (size_t)M * CD * 2;
constexpr size_t WS_R1_END = WS_YB + (size_t)M * CD * 2;
constexpr size_t WS_ACT = WS_R1;
constexpr size_t WS_END = (WS_R1_END > WS_ACT + (size_t)M * DFF * 2) ? WS_R1_END : WS_ACT + (size_t)M * DFF * 2;
static_assert(WS_ACT + (size_t)M * DFF * 2 + (size_t)P5_SPLIT * MS * D * 4 + (size_t)M * D * 2 <= WS_R1_END, "ACT + PART5 + XB overlay fits");
static_assert(WS_MRG == WS_H + (size_t)M * D * 2 && WS_R1 >= WS_H + (size_t)P8_SPLIT * MS * D * 4, "PART8 overlay fits");
static_assert((D / 128) % P5_SPLIT == 0 && (DFF / 128) % P8_SPLIT == 0 && 16 * P5_SPLIT <= 256 && 16 * P8_SPLIT <= 256, "piece geometry");

constexpr int LDS_BYTES = 147456;
constexpr int NTHREADS = 512;

__device__ __forceinline__ unsigned cvt_pk_bf16(float lo, float hi) { unsigned r; asm volatile("v_cvt_pk_bf16_f32 %0, %1, %2" : "=v"(r) : "v"(lo), "v"(hi)); return r; }
__device__ __forceinline__ float bf_lo(unsigned w) { return __uint_as_float(w << 16); }
__device__ __forceinline__ float bf_hi(unsigned w) { return __uint_as_float(w & 0xffff0000u); }
__device__ __forceinline__ float sigmoidf_(float x) { return __builtin_amdgcn_rcpf(1.0f + __expf(-x)); }
__device__ __forceinline__ float siluf_(float x) { return x * sigmoidf_(x); }
__device__ __forceinline__ float gelu_tanh(float x) { return x * sigmoidf_(1.5957691216057308f * (x + 0.044715f * x * x * x)); }
__device__ __forceinline__ float wave_sum(float v) {
#pragma unroll
    for (int o = 1; o < 64; o <<= 1) v += __shfl_xor(v, o);
    return v;
}
__device__ __forceinline__ int mod_row(int r) { return r < MP ? (r >> 11) : NBP + ((r - MP) >> 2); }


#define XB_TMO      128
#define XB_XCNT(j)  (256  + 64 * (j))
#define XB_XSUB(j)  (1280 + 64 * (j))
#define XB_XGEN(j)  (2304 + 64 * (j))
#define XB_TOP      3328
#define XB_TOPGEN   3392
#define XCD_BAR_WORDS 3456
#define XB_SPIN_CAP (1u << 18)
__device__ __forceinline__ unsigned xb_ld(unsigned* p)              { return __hip_atomic_load(p, __ATOMIC_RELAXED, __HIP_MEMORY_SCOPE_AGENT); }
__device__ __forceinline__ unsigned xb_add(unsigned* p, unsigned v) { return __hip_atomic_fetch_add(p, v, __ATOMIC_RELAXED, __HIP_MEMORY_SCOPE_AGENT); }
__device__ __forceinline__ unsigned xb_xcc_id() { return (unsigned)__builtin_amdgcn_s_getreg((3 << 11) | 20) & 0xFu; }
#define XB_SPIN(cond, bar) do { unsigned _sp = 0; while (cond) { __builtin_amdgcn_s_sleep(1); \
    if ((++_sp & 255u) == 0u) { if (xb_ld(&(bar)[XB_TMO])) break; if (_sp > XB_SPIN_CAP) { atomicAdd(&(bar)[XB_TMO], 1u); break; } } } } while (0)
struct XcdBarrier { unsigned* bar; unsigned x; volatile LAS unsigned* st; };
__device__ __forceinline__ XcdBarrier xcd_barrier_post(unsigned* bar, volatile LAS unsigned* st) {
    XcdBarrier b; b.bar = bar; b.x = xb_xcc_id(); b.st = st;
    if (threadIdx.x == 0) (void)xb_add(&bar[XB_XCNT(b.x)], 1u);
    return b;
}
__device__ __forceinline__ void xcd_barrier_complete(unsigned* bar, unsigned x, unsigned& nloc, unsigned& nx) {
    const unsigned G = gridDim.x * gridDim.y * gridDim.z;
    unsigned sum, cnt, mine, sp = 0u;
    for (;;) {
        sum = 0u; cnt = 0u; mine = 0u;
#pragma unroll
        for (unsigned j = 0; j < 16; ++j) { const unsigned c = xb_ld(&bar[XB_XCNT(j)]); sum += c; cnt += (c > 0u) ? 1u : 0u; mine = (j == x) ? c : mine; }
        if (sum == G) break;
        __builtin_amdgcn_s_sleep(1);
        if ((++sp & 255u) == 0u) { if (xb_ld(&bar[XB_TMO])) break; if (sp > XB_SPIN_CAP) { atomicAdd(&bar[XB_TMO], 1u); break; } }
    }
    nloc = mine > 0u ? mine : 1u; nx = cnt > 0u ? cnt : 1u;
}
__device__ __forceinline__ void xcd_barrier(const XcdBarrier& b) {
    asm volatile("s_waitcnt vmcnt(0)" ::: "memory");
    __syncthreads();
    if (threadIdx.x == 0) {
        unsigned* bar = b.bar;
        __builtin_amdgcn_s_waitcnt(0);
        unsigned nloc = b.st[0], nx = b.st[1];
        if (nloc == 0u) { xcd_barrier_complete(bar, b.x, nloc, nx); b.st[0] = nloc; b.st[1] = nx; }
        const unsigned old = xb_add(&bar[XB_XSUB(b.x)], 1u);
        const unsigned gen = old / nloc;
        if (old + 1u == (gen + 1u) * nloc) {
            __builtin_amdgcn_fence(__ATOMIC_RELEASE, "agent");
            asm volatile("s_waitcnt vmcnt(0)" ::: "memory");
            const unsigned og = xb_add(&bar[XB_TOP], 1u);
            const unsigned tg = og / nx;
            if (og + 1u == (tg + 1u) * nx) xb_add(&bar[XB_TOPGEN], 1u);
            else XB_SPIN(xb_ld(&bar[XB_TOPGEN]) == tg, bar);
            __builtin_amdgcn_fence(__ATOMIC_ACQUIRE, "agent");
            xb_add(&bar[XB_XGEN(b.x)], 1u);
            asm volatile("s_waitcnt vmcnt(0)" ::: "memory");
        } else {
            XB_SPIN(xb_ld(&bar[XB_XGEN(b.x)]) == gen, bar);
            __builtin_amdgcn_fence(__ATOMIC_ACQUIRE, "agent");
            asm volatile("s_waitcnt vmcnt(0)" ::: "memory");
        }
    }
    __syncthreads();
}

namespace pg8 {
constexpr int BM = 256, BK = 64, HALF = 128, HTB = HALF * BK * 2, STAGE_BYTES = 8 * HTB, NXCD = 8, WGM = 8;
__host__ __device__ __forceinline__ int lds_byte(int r, int c) { const int st = (r >> 4) * 2 + (c >> 5), rr = r & 15, cc = c & 31, ob = rr * 64 + cc * 2; return st * 1024 + (ob ^ (((ob >> 9) & 1) << 5)); }
__host__ __device__ __forceinline__ void stage_rc(int b, int& R, int& C) { const int st = b / 1024, sb = b % 1024, swz = sb ^ (((sb >> 9) & 1) << 5); R = (st >> 1) * 16 + swz / 64; C = (st & 1) * 32 + (swz % 64) / 2; }
__host__ __device__ __forceinline__ int perm32(int rho) { const int n = rho >> 4, i = rho & 15; return 8 * (i >> 2) + 4 * n + (i & 3); }

struct Unit { const char* A; const char* B; int nk, pm, pn, aux, keep; };

struct TileOrder {
    int nM, nN, nwg, G, c;
    __device__ void init(int nM_, int nN_, int G_, int c_) { nM = nM_; nN = nN_; nwg = nM * nN; G = G_; c = c_; }
    __device__ bool tile(int i, int& pm, int& pn) const {
        const long L = (long)i * G + c; if (L >= nwg) return false;
        int wgid = (int)L; { const int q = nwg / NXCD, r = nwg % NXCD, xcd = wgid % NXCD, off = wgid / NXCD; wgid = (xcd < r ? xcd * (q + 1) : r * (q + 1) + (xcd - r) * q) + off; }
        const int nig = WGM * nN, gid = wgid / nig, fm = gid * WGM, gsz = (nM - fm) < WGM ? (nM - fm) : WGM;
        pm = fm + ((wgid % nig) % gsz); pn = (wgid % nig) / gsz; return true;
    }
};
struct SchedPlain {
    TileOrder o; const char* A; const char* B; size_t tsA, tsB; int nk;
    __device__ bool next(int i, Unit& u) const { int pm, pn; if (!o.tile(i, pm, pn)) return false; u.A = A + (size_t)pm * tsA; u.B = B + (size_t)pn * tsB; u.nk = nk; u.pm = pm; u.pn = pn; u.aux = 0; u.keep = 0; return true; }
};
struct SchedDual {
    TileOrder o; const char* A0; const char* B0; const char* A1; const char* B1; size_t tsA, tsB; int nk;
    __device__ bool next(int i, Unit& u) const { int pm, pn; if (!o.tile(i >> 1, pm, pn)) return false; const int s = i & 1;
        u.A = (s ? A1 : A0) + (size_t)pm * tsA; u.B = (s ? B1 : B0) + (size_t)pn * tsB; u.nk = nk; u.pm = pm; u.pn = pn; u.aux = s; u.keep = !s; return true; }
};

struct SchedSplit {
    TileOrder o; int S, PP, G, c; const char* A; const char* B; size_t tsA, tsB; int nkfull;
    __device__ void init(int nN, int S_, int PP_, int nkfull_, int G_, int c_) { o.init(MP / 256, nN, G_, c_); S = S_; PP = PP_; G = G_; c = c_; nkfull = nkfull_; }
    __device__ bool next(int i, Unit& u) const {
        const int R = (o.nwg - c + G - 1) / G;
        if (i < R) { int pm, pn; o.tile(i, pm, pn); u.A = A + (size_t)pm * tsA; u.B = B + (size_t)pn * tsB; u.nk = nkfull; u.pm = pm; u.pn = pn; u.aux = 0; u.keep = 0; return true; }
        const int idx = c + (i - R) * G; if (idx >= 2 * o.nN * S) return false;
        const int j = idx / S, sp = idx % S; u.pm = MP / 256 + j / o.nN; u.pn = j % o.nN;
        u.A = A + (size_t)u.pm * tsA + (size_t)sp * PP * 256; u.B = B + (size_t)u.pn * tsB + (size_t)sp * PP * 256; u.nk = 2 * PP; u.aux = 1 + sp; u.keep = 0; return true;
    }
};

template <class Epi, class Sched>
__device__ __forceinline__ void gemm_phase(LAS unsigned char* lds, int lda, int ldb, const Sched& S, const Epi& E) {
    const int tid = threadIdx.x, wid = __builtin_amdgcn_readfirstlane(tid >> 6), lane = tid & 63, wr = wid >> 2, wc = wid & 3, fr = lane & 15, fq = lane >> 4;
    unsigned voffA[2], voffB[2];
#pragma unroll
    for (int i = 0; i < 2; ++i) { int R, C; stage_rc(tid * 16 + i * 8192, R, C); const int Rb = Epi::PERM ? ((R & ~31) + perm32(R & 31)) : R;
        voffA[i] = (unsigned)(R * lda + C) * 2u; voffB[i] = (unsigned)(Rb * ldb + C) * 2u; }
    const size_t kstep = (size_t)(BK * 2);
    const size_t hstepA = (size_t)HALF * lda * 2, hstepB = (size_t)HALF * ldb * 2;
    const unsigned ldsw = (unsigned)wid * 1024u;
    const int aoff = lds_byte(wr * 64 + fr, fq * 8), boff = lds_byte(wc * 32 + fr, fq * 8);
#define PG8_SA(b, h) (((b) * 2 + (h)) * HTB)
#define PG8_SB(b, h) ((4 + (b) * 2 + (h)) * HTB)
#define PG8_STAGE(bufoff, gbase, voff) do { _Pragma("unroll") for (int _i = 0; _i < 2; ++_i) \
        __builtin_amdgcn_global_load_lds((const unsigned*)((const char*)(gbase) + (voff)[_i]), (LAS unsigned*)(lds + (bufoff) + ldsw + _i * 8192), 16, 0, 0); } while (0)
#define PG8_LDA(dst, b, h) do { _Pragma("unroll") for (int m = 0; m < 4; ++m) _Pragma("unroll") for (int k = 0; k < 2; ++k) dst[m][k] = *(const LAS bf16x8*)(lds + PG8_SA(b, h) + aoff + m * 2048 + k * 1024); } while (0)
#define PG8_LDB(dst, b, h) do { _Pragma("unroll") for (int n = 0; n < 2; ++n) _Pragma("unroll") for (int k = 0; k < 2; ++k) dst[n][k] = *(const LAS bf16x8*)(lds + PG8_SB(b, h) + boff + n * 2048 + k * 1024); } while (0)
#define PG8_MMA(ai, bj, At, Bt) do { __builtin_amdgcn_s_setprio(1); _Pragma("unroll") for (int m = 0; m < 4; ++m) _Pragma("unroll") for (int n = 0; n < 2; ++n) _Pragma("unroll") for (int k = 0; k < 2; ++k) \
        acc[ai][bj][m][n] = __builtin_amdgcn_mfma_f32_16x16x32_bf16(Bt[n][k], At[m][k], acc[ai][bj][m][n], 0, 0, 0); __builtin_amdgcn_s_setprio(0); } while (0)
#define PG8_WAIT_V(n) asm volatile("s_waitcnt vmcnt(" #n ")" ::: "memory")
#define PG8_WAIT_L(n) asm volatile("s_waitcnt lgkmcnt(" #n ")" ::: "memory")
#define PG8_BAR __builtin_amdgcn_s_barrier()
#define PG8_SCHED __builtin_amdgcn_sched_barrier(0)
    Unit cur, nxt; int ui = 0;
    if (!S.next(0, cur)) return;
    f32x4 acc[2][2][4][2];
#pragma unroll
    for (int a = 0; a < 2; ++a)
#pragma unroll
        for (int b = 0; b < 2; ++b)
#pragma unroll
            for (int m = 0; m < 4; ++m)
#pragma unroll
                for (int n = 0; n < 2; ++n) acc[a][b][m][n] = (f32x4){0.f, 0.f, 0.f, 0.f};
    bf16x8 At[4][2], B0[2][2], B1[2][2];
    const char* cA = cur.A; const char* cB = cur.B;
    PG8_STAGE(PG8_SB(0, 0), cB, voffB); PG8_STAGE(PG8_SB(0, 1), cB + hstepB, voffB); PG8_STAGE(PG8_SA(0, 0), cA, voffA); PG8_STAGE(PG8_SA(0, 1), cA + hstepA, voffA);
    if (wr == 1) PG8_BAR;
    PG8_WAIT_V(2); PG8_BAR;
    PG8_STAGE(PG8_SB(1, 0), cB + kstep, voffB); PG8_STAGE(PG8_SA(1, 0), cA + kstep, voffA); PG8_STAGE(PG8_SB(1, 1), cB + hstepB + kstep, voffB);
    PG8_WAIT_V(6); PG8_BAR;
    for (;;) {
        const bool has_next = S.next(ui + 1, nxt);
        const char* nA = has_next ? nxt.A : cA; const char* nB = has_next ? nxt.B : cB;
        const int nt = cur.nk;
        for (int t = 0; t < nt; t += 2) {
            const bool last = (t == nt - 2);
            const char* a1 = cA + (size_t)(t + 1) * kstep;
            const char* a2 = last ? nA : cA + (size_t)(t + 2) * kstep; const char* b2 = last ? nB : cB + (size_t)(t + 2) * kstep;
            const char* a3 = a2 + kstep; const char* b3 = b2 + kstep;
            PG8_LDB(B0, 0, 0); PG8_LDB(B1, 0, 1); PG8_SCHED; PG8_LDA(At, 0, 0); PG8_STAGE(PG8_SA(1, 1), a1 + hstepA, voffA);
            PG8_WAIT_V(8); PG8_WAIT_L(0); PG8_BAR; PG8_MMA(0, 0, At, B0); PG8_MMA(0, 1, At, B1); PG8_BAR; PG8_SCHED;
            PG8_LDA(At, 0, 1); PG8_STAGE(PG8_SB(0, 0), b2, voffB); PG8_STAGE(PG8_SB(0, 1), b2 + hstepB, voffB); PG8_STAGE(PG8_SA(0, 0), a2, voffA);
            PG8_WAIT_V(8); PG8_WAIT_L(0); PG8_BAR; PG8_MMA(1, 0, At, B0); PG8_MMA(1, 1, At, B1); PG8_BAR; PG8_SCHED;
            PG8_LDB(B0, 1, 0); PG8_LDB(B1, 1, 1); PG8_SCHED; PG8_LDA(At, 1, 0); PG8_STAGE(PG8_SA(0, 1), a2 + hstepA, voffA);
            PG8_WAIT_V(8); PG8_WAIT_L(0); PG8_BAR; PG8_MMA(0, 0, At, B0); PG8_MMA(0, 1, At, B1); PG8_BAR; PG8_SCHED;
            PG8_LDA(At, 1, 1); PG8_STAGE(PG8_SB(1, 0), b3, voffB); PG8_STAGE(PG8_SB(1, 1), b3 + hstepB, voffB); PG8_STAGE(PG8_SA(1, 0), a3, voffA);
            PG8_WAIT_V(8); PG8_WAIT_L(0); PG8_BAR; PG8_MMA(1, 0, At, B0); PG8_MMA(1, 1, At, B1); PG8_BAR; PG8_SCHED;
        }
        if (wr == 0) PG8_BAR;
        E(acc, cur, wr, wc, fr, fq);
        if (!has_next) break;
        if (!cur.keep) {
#pragma unroll
            for (int a = 0; a < 2; ++a)
#pragma unroll
                for (int b = 0; b < 2; ++b)
#pragma unroll
                    for (int m = 0; m < 4; ++m)
#pragma unroll
                        for (int n = 0; n < 2; ++n) acc[a][b][m][n] = (f32x4){0.f, 0.f, 0.f, 0.f};
        }
        cur = nxt; cA = nA; cB = nB; ++ui;
        if (wr == 1) PG8_BAR;
    }
    PG8_WAIT_V(0);
    PG8_BAR;
#undef PG8_SA
#undef PG8_SB
#undef PG8_STAGE
#undef PG8_LDA
#undef PG8_LDB
#undef PG8_MMA
#undef PG8_WAIT_V
#undef PG8_WAIT_L
#undef PG8_BAR
#undef PG8_SCHED
}

__device__ __forceinline__ void st8(bf16_t* p, f32x4 v0, f32x4 v1) {
    u32x4 w; w.x = cvt_pk_bf16(v0[0], v0[1]); w.y = cvt_pk_bf16(v0[2], v0[3]); w.z = cvt_pk_bf16(v1[0], v1[1]); w.w = cvt_pk_bf16(v1[2], v1[3]);
    *(u32x4*)p = w;
}
template <int ACT> __device__ __forceinline__ f32x4 act4(f32x4 v) {
    if (ACT == 1) { return (f32x4){gelu_tanh(v[0]), gelu_tanh(v[1]), gelu_tanh(v[2]), gelu_tanh(v[3])}; }
    if (ACT == 2) { return (f32x4){sigmoidf_(v[0]), sigmoidf_(v[1]), sigmoidf_(v[2]), sigmoidf_(v[3])}; }
    return v;
}
struct EpiIn {
    static constexpr bool PERM = true;
    bf16_t *BG, *Z, *U, *V, *GA, *GB; float* VSS;
    __device__ __forceinline__ void operator()(f32x4 (&acc)[2][2][4][2], const Unit& u, int wr, int wc, int fr, int fq) const {
        const int row0 = u.pm * BM + wr * 64 + fr, cl = wc * 32 + 8 * fq, pn = u.pn;
        bf16_t* dst; int ld, mode, coff;
        if (pn < 4) { dst = BG; ld = CD; mode = 0; coff = pn * 256; }
        else if (pn < 12) { dst = Z; ld = CD; mode = 3; coff = (pn - 4) * 128; }
        else if (pn < 16) { dst = U; ld = CD; mode = 1; coff = (pn - 12) * 256; }
        else if (pn < 20) { dst = V; ld = CD; mode = 1; coff = (pn - 16) * 256; }
        else if (pn < 28) { dst = GA; ld = D; mode = 2; coff = (pn - 20) * 256; }
        else { dst = GB; ld = D; mode = 2; coff = (pn - 28) * 256; }
        bf16_t* base = dst + (size_t)row0 * ld + coff + cl; const bool isv = (pn >= 16 && pn < 20);
        if (mode == 3) {
#pragma unroll
            for (int ai = 0; ai < 2; ++ai)
#pragma unroll
                for (int m = 0; m < 4; ++m) { st8(base + (size_t)(ai * HALF + m * 16) * ld, acc[ai][0][m][0] * acc[ai][1][m][0], acc[ai][0][m][1] * acc[ai][1][m][1]); asm volatile("" ::: "memory"); }
        } else {
#pragma unroll
            for (int ai = 0; ai < 2; ++ai)
#pragma unroll
                for (int m = 0; m < 4; ++m) { bf16_t* rowp = base + (size_t)(ai * HALF + m * 16) * ld; float ss = 0.f;
#pragma unroll
                    for (int bj = 0; bj < 2; ++bj) { f32x4 v0 = acc[ai][bj][m][0], v1 = acc[ai][bj][m][1];
                        if (mode == 1) { v0 = act4<1>(v0); v1 = act4<1>(v1); } else if (mode == 2) { v0 = act4<2>(v0); v1 = act4<2>(v1); }
                        st8(rowp + bj * HALF, v0, v1);
                        if (isv) ss += (v0[0] * v0[0] + v0[1] * v0[1]) + (v0[2] * v0[2] + v0[3] * v0[3]) + (v1[0] * v1[0] + v1[1] * v1[1]) + (v1[2] * v1[2] + v1[3] * v1[3]); }
                    if (isv) { ss += __shfl_xor(ss, 16); ss += __shfl_xor(ss, 32); if (fq == 0) __hip_atomic_fetch_add(VSS + row0 + ai * HALF + m * 16, ss, __ATOMIC_RELAXED, __HIP_MEMORY_SCOPE_AGENT); }
                    asm volatile("" ::: "memory"); }
        }
    }
};
struct EpiMerge {
    static constexpr bool PERM = true;
    const bf16_t *GA, *GB; bf16_t* MRG;
    __device__ __forceinline__ void operator()(f32x4 (&acc)[2][2][4][2], const Unit& u, int wr, int wc, int fr, int fq) const {
        const int row0 = u.pm * BM + wr * 64 + fr, col0 = u.pn * BM + wc * 32 + 8 * fq;
        if (u.aux == 0) {
#pragma unroll
            for (int ai = 0; ai < 2; ++ai)
#pragma unroll
                for (int m = 0; m < 4; ++m) { const size_t off = (size_t)(row0 + ai * HALF + m * 16) * D + col0;
#pragma unroll
                    for (int bj = 0; bj < 2; ++bj) {
                        const u32x4 gb = *(const u32x4*)(GB + off + bj * HALF), ga = *(const u32x4*)(GA + off + bj * HALF);
                        const f32x4 b0 = (f32x4){bf_lo(gb.x), bf_hi(gb.x), bf_lo(gb.y), bf_hi(gb.y)}, b1 = (f32x4){bf_lo(gb.z), bf_hi(gb.z), bf_lo(gb.w), bf_hi(gb.w)};
                        const f32x4 a0 = (f32x4){bf_lo(ga.x), bf_hi(ga.x), bf_lo(ga.y), bf_hi(ga.y)}, a1 = (f32x4){bf_lo(ga.z), bf_hi(ga.z), bf_lo(ga.w), bf_hi(ga.w)};
#pragma unroll
                        for (int j = 0; j < 4; ++j) { acc[ai][bj][m][0][j] *= a0[j] * __builtin_amdgcn_rcpf(fmaxf(b0[j], 1e-20f)); acc[ai][bj][m][1][j] *= a1[j] * __builtin_amdgcn_rcpf(fmaxf(b1[j], 1e-20f)); }
                    } }
        } else {
            u32x4 cgb[2];
#pragma unroll
            for (int bj = 0; bj < 2; ++bj) cgb[bj] = *(const u32x4*)(GB + (size_t)row0 * D + col0 + bj * HALF);
#pragma unroll
            for (int ai = 0; ai < 2; ++ai)
#pragma unroll
                for (int m = 0; m < 4; ++m) { const size_t off = (size_t)(row0 + ai * HALF + m * 16) * D + col0;
                    u32x4 ngb[2];
                    if (ai * 4 + m < 7) { const int g2 = ai * 4 + m + 1; const size_t off2 = (size_t)(row0 + (g2 >> 2) * HALF + (g2 & 3) * 16) * D + col0;
#pragma unroll
                        for (int bj = 0; bj < 2; ++bj) ngb[bj] = *(const u32x4*)(GB + off2 + bj * HALF); }
#pragma unroll
                    for (int bj = 0; bj < 2; ++bj) { const u32x4 gb = cgb[bj];
                        f32x4 b0 = (f32x4){bf_lo(gb.x), bf_hi(gb.x), bf_lo(gb.y), bf_hi(gb.y)}, b1 = (f32x4){bf_lo(gb.z), bf_hi(gb.z), bf_lo(gb.w), bf_hi(gb.w)};
#pragma unroll
                        for (int j = 0; j < 4; ++j) { b0[j] = fmaxf(b0[j], 1e-20f); b1[j] = fmaxf(b1[j], 1e-20f); }
                        st8(MRG + off + bj * HALF, acc[ai][bj][m][0] * b0, acc[ai][bj][m][1] * b1); }
#pragma unroll
                    for (int bj = 0; bj < 2; ++bj) cgb[bj] = ngb[bj];
                }
        }
    }
};
template <bool BASE_BF16> struct EpiResidSplit {
    static constexpr bool PERM = true;
    const void* base; bf16_t* XB; bf16_t* PART; const float* gate;
    __device__ __forceinline__ void ld_base(int r, int col0, f32x4 (&b)[2][2]) const {
#pragma unroll
        for (int bj = 0; bj < 2; ++bj) {
            if (BASE_BF16) { const u32x4 p = *(const u32x4*)((const bf16_t*)base + (size_t)r * D + col0 + bj * HALF); b[bj][0] = (f32x4){bf_lo(p.x), bf_hi(p.x), bf_lo(p.y), bf_hi(p.y)}; b[bj][1] = (f32x4){bf_lo(p.z), bf_hi(p.z), bf_lo(p.w), bf_hi(p.w)}; }
            else { const float* bp = (const float*)base + (size_t)r * D + col0 + bj * HALF; b[bj][0] = __builtin_nontemporal_load((const f32x4*)bp); b[bj][1] = __builtin_nontemporal_load((const f32x4*)(bp + 4)); } }
    }
    __device__ __forceinline__ void ld_gate(int r, int col0, f32x4 (&g)[2][2]) const {
        const float* gp = gate + (size_t)mod_row(r) * NMOD + col0;
#pragma unroll
        for (int bj = 0; bj < 2; ++bj) { g[bj][0] = *(const f32x4*)(gp + bj * HALF); g[bj][1] = *(const f32x4*)(gp + bj * HALF + 4); }
    }
    __device__ __forceinline__ void operator()(f32x4 (&acc)[2][2][4][2], const Unit& u, int wr, int wc, int fr, int fq) const {
        const int row0 = u.pm * BM + wr * 64 + fr, col0 = u.pn * BM + wc * 32 + 8 * fq;
        if (u.aux == 0) {
            f32x4 gt[2][2], cb[2][2];
            ld_gate(row0, col0, gt); ld_base(row0, col0, cb);
#pragma unroll
            for (int ai = 0; ai < 2; ++ai)
#pragma unroll
                for (int m = 0; m < 4; ++m) { const int r = row0 + ai * HALF + m * 16; f32x4 nb[2][2];
                    if (ai * 4 + m < 7) { const int g2 = ai * 4 + m + 1; ld_base(row0 + (g2 >> 2) * HALF + (g2 & 3) * 16, col0, nb); }
                    bf16_t* op = XB + (size_t)r * D + col0;
#pragma unroll
                    for (int bj = 0; bj < 2; ++bj) st8(op + bj * HALF, cb[bj][0] + gt[bj][0] * acc[ai][bj][m][0], cb[bj][1] + gt[bj][1] * acc[ai][bj][m][1]);
#pragma unroll
                    for (int bj = 0; bj < 2; ++bj)
#pragma unroll
                        for (int n = 0; n < 2; ++n) cb[bj][n] = nb[bj][n];
                }
        } else {
            f32x4 cg[2][2];
            ld_gate(row0, col0, cg);
#pragma unroll
            for (int ai = 0; ai < 2; ++ai)
#pragma unroll
                for (int m = 0; m < 4; ++m) { const int r = row0 + ai * HALF + m * 16; f32x4 ng[2][2];
                    if (ai * 4 + m < 7) { const int g2 = ai * 4 + m + 1; ld_gate(row0 + (g2 >> 2) * HALF + (g2 & 3) * 16, col0, ng); }
                    bf16_t* op = PART + ((size_t)(u.aux - 1) * MS + (size_t)(r - MP)) * D + col0;
#pragma unroll
                    for (int bj = 0; bj < 2; ++bj) st8(op + bj * HALF, cg[bj][0] * acc[ai][bj][m][0], cg[bj][1] * acc[ai][bj][m][1]);
#pragma unroll
                    for (int bj = 0; bj < 2; ++bj)
#pragma unroll
                        for (int n = 0; n < 2; ++n) cg[bj][n] = ng[bj][n];
                }
        }
    }
};
struct EpiSwiglu {
    static constexpr bool PERM = true;
    bf16_t* ACT;
    __device__ __forceinline__ void operator()(f32x4 (&acc)[2][2][4][2], const Unit& u, int wr, int wc, int fr, int fq) const {
        bf16_t* base = ACT + (size_t)(u.pm * BM + wr * 64 + fr) * DFF + u.pn * 128 + wc * 32 + 8 * fq;
#pragma unroll
        for (int ai = 0; ai < 2; ++ai)
#pragma unroll
            for (int m = 0; m < 4; ++m) { f32x4 v0, v1;
#pragma unroll
                for (int j = 0; j < 4; ++j) { v0[j] = siluf_(acc[ai][0][m][0][j]) * acc[ai][1][m][0][j]; v1[j] = siluf_(acc[ai][0][m][1][j]) * acc[ai][1][m][1][j]; }
                st8(base + (size_t)(ai * HALF + m * 16) * DFF, v0, v1); }
    }
};
}

struct Args {
    const float *x_prompt, *x_sample, *state_conv, *c_prompt, *c_sample, *g_mix, *g_ffn, *w_ada, *b_ada, *w_in, *w_conv, *g_v, *w_sg, *b_sg, *w_pa, *w_pb, *w_out, *w_ffn_in, *w_ffn_out, *g_final;
    float* out; unsigned char* ws; int ph_lo, ph_hi, li, pad;
};

struct CopyItem { const float* W; bf16_t* WT; int K, N, k0, n0, drow0; };
__device__ __forceinline__ void copy_load(const CopyItem& c, f32x4 (&v)[16], int lane) {
    const int nl = lane & 15, q = lane >> 4;
#pragma unroll
    for (int i = 0; i < 16; ++i) v[i] = __builtin_nontemporal_load((const f32x4*)(c.W + (size_t)(c.k0 + 16 * q + i) * c.N + c.n0 + 4 * nl));
}
__device__ __forceinline__ void copy_finish(const CopyItem& c, const f32x4 (&v)[16], LAS bf16_t* T, int lane) {
    const int nl = lane & 15, q = lane >> 4;
#pragma unroll
    for (int j = 0; j < 4; ++j) {
        u32x4 p0, p1;
        p0.x = cvt_pk_bf16(v[0][j], v[1][j]); p0.y = cvt_pk_bf16(v[2][j], v[3][j]); p0.z = cvt_pk_bf16(v[4][j], v[5][j]); p0.w = cvt_pk_bf16(v[6][j], v[7][j]);
        p1.x = cvt_pk_bf16(v[8][j], v[9][j]); p1.y = cvt_pk_bf16(v[10][j], v[11][j]); p1.z = cvt_pk_bf16(v[12][j], v[13][j]); p1.w = cvt_pk_bf16(v[14][j], v[15][j]);
        LAS u32x4* dst = (LAS u32x4*)(T + (4 * nl + j) * 72 + 16 * q);
        dst[0] = p0; dst[1] = p1;
    }
    asm volatile("s_waitcnt lgkmcnt(0)" ::: "memory");
    const int kc = (lane & 7) * 8;
#pragma unroll
    for (int jj = 0; jj < 8; ++jj) { const int n = (lane >> 3) + 8 * jj; const u32x4 o = *(const LAS u32x4*)(T + n * 72 + kc); *(u32x4*)(c.WT + (size_t)(c.drow0 + n) * c.K + c.k0 + kc) = o; }
    asm volatile("s_waitcnt lgkmcnt(0)" ::: "memory");
}
__device__ __forceinline__ int win_vrow(int n0) {
    if (n0 < 1024 || n0 >= 3072) return n0;
    if (n0 < 2048) { const int q = n0 - 1024; return 1024 + (q >> 7) * 256 + (q & 127); }
    const int q = n0 - 2048; return 1024 + (q >> 7) * 256 + 128 + (q & 127);
}
__device__ __forceinline__ int wfi_vrow(int n0) {
    if (n0 < DFF) return (n0 >> 7) * 256 + (n0 & 127);
    const int q = n0 - DFF; return (q >> 7) * 256 + 128 + (q & 127);
}
constexpr int IT_WIN = (D / 64) * (NIN / 64), IT_WPA = (CD / 64) * (D / 64), IT_WOUT = (D / 64) * (D / 64), IT_WFI = (D / 64) * (NFI / 64), IT_WFO = (DFF / 64) * (D / 64);
constexpr int IT_TOTAL = IT_WIN + 2 * IT_WPA + IT_WOUT + IT_WFI + IT_WFO;
constexpr int SC_ROWS = 144, MOD_ITEMS = NMOD / 64;
constexpr int CW_SCDONE = 192, CW_MODDONE = 256, CW_XQ = 320;
constexpr int MT_STRIDE = 264;

__device__ __forceinline__ CopyItem copy_decode(const Args& a, int it, bf16_t* WIN, bf16_t* WPA, bf16_t* WPB, bf16_t* WOUT, bf16_t* WFI, bf16_t* WFO) {
    CopyItem c;
    if (it < IT_WIN) { const int nb = it % (NIN / 64), kb = it / (NIN / 64); c = CopyItem{a.w_in, WIN, D, NIN, kb * 64, nb * 64, win_vrow(nb * 64)}; return c; } it -= IT_WIN;
    if (it < IT_WPA) { const int nb = it % (D / 64), kb = it / (D / 64); c = CopyItem{a.w_pa, WPA, CD, D, kb * 64, nb * 64, nb * 64}; return c; } it -= IT_WPA;
    if (it < IT_WPA) { const int nb = it % (D / 64), kb = it / (D / 64); c = CopyItem{a.w_pb, WPB, CD, D, kb * 64, nb * 64, nb * 64}; return c; } it -= IT_WPA;
    if (it < IT_WOUT) { const int nb = it % (D / 64), kb = it / (D / 64); c = CopyItem{a.w_out, WOUT, D, D, kb * 64, nb * 64, nb * 64}; return c; } it -= IT_WOUT;
    if (it < IT_WFI) { const int nb = it % (NFI / 64), kb = it / (NFI / 64); c = CopyItem{a.w_ffn_in, WFI, D, NFI, kb * 64, nb * 64, wfi_vrow(nb * 64)}; return c; } it -= IT_WFI;
    { const int nb = it % (D / 64), kb = it / (D / 64); c = CopyItem{a.w_ffn_out, WFO, DFF, D, kb * 64, nb * 64, nb * 64}; return c; }
}

__device__ __forceinline__ void mod_item(const Args& a, const bf16_t* SC, float* MOD, LAS unsigned char* lds, int item, int tid) {
    const int lane = tid & 63, w = __builtin_amdgcn_readfirstlane(tid >> 6), fr = lane & 15, fq = lane >> 4, n0 = item * 64;
    const int c4 = tid & 15, kp = tid >> 4;
    f32x4 acc[2][4];
#pragma unroll
    for (int i = 0; i < 4; ++i) { acc[0][i] = (f32x4){0.f, 0.f, 0.f, 0.f}; acc[1][i] = acc[0][i]; }
    const float* wbase = a.w_ada + n0 + 4 * c4;
    f32x4 wv[8];
#pragma unroll
    for (int j = 0; j < 4; ++j) { const int k = 2 * (kp + 32 * j); wv[2 * j] = __builtin_nontemporal_load((const f32x4*)(wbase + (size_t)k * NMOD)); wv[2 * j + 1] = __builtin_nontemporal_load((const f32x4*)(wbase + (size_t)(k + 1) * NMOD)); }
#pragma unroll 1
    for (int c = 0; c < 8; ++c) {
        LAS bf16_t* T = (LAS bf16_t*)(lds + (c & 1) * (64 * MT_STRIDE * 2));
#pragma unroll
        for (int j = 0; j < 4; ++j) { const int k = 2 * (kp + 32 * j);
#pragma unroll
            for (int i = 0; i < 4; ++i) *(LAS unsigned*)(T + (4 * c4 + i) * MT_STRIDE + k) = cvt_pk_bf16(wv[2 * j][i], wv[2 * j + 1][i]); }
        bf16x8 af[8], af2[8];
#pragma unroll
        for (int ks = 0; ks < 8; ++ks) af[ks] = *(const bf16x8*)(SC + (size_t)(16 * w + fr) * D + c * 256 + ks * 32 + 8 * fq);
        if (w == 0) {
#pragma unroll
            for (int ks = 0; ks < 8; ++ks) af2[ks] = *(const bf16x8*)(SC + (size_t)(128 + fr) * D + c * 256 + ks * 32 + 8 * fq);
        }
        if (c + 1 < 8) {
#pragma unroll
            for (int j = 0; j < 4; ++j) { const int k = (c + 1) * 256 + 2 * (kp + 32 * j); wv[2 * j] = __builtin_nontemporal_load((const f32x4*)(wbase + (size_t)k * NMOD)); wv[2 * j + 1] = __builtin_nontemporal_load((const f32x4*)(wbase + (size_t)(k + 1) * NMOD)); }
        }
        asm volatile("s_waitcnt lgkmcnt(0)" ::: "memory"); __builtin_amdgcn_s_barrier(); asm volatile("" ::: "memory");
#pragma unroll
        for (int ks = 0; ks < 8; ++ks) {
            bf16x8 bfr[4];
#pragma unroll
            for (int nb = 0; nb < 4; ++nb) bfr[nb] = *(const LAS bf16x8*)(T + (16 * nb + fr) * MT_STRIDE + ks * 32 + 8 * fq);
#pragma unroll
            for (int nb = 0; nb < 4; ++nb) acc[0][nb] = __builtin_amdgcn_mfma_f32_16x16x32_bf16(af[ks], bfr[nb], acc[0][nb], 0, 0, 0);
            if (w == 0) {
#pragma unroll
                for (int nb = 0; nb < 4; ++nb) acc[1][nb] = __builtin_amdgcn_mfma_f32_16x16x32_bf16(af2[ks], bfr[nb], acc[1][nb], 0, 0, 0);
            }
        }
    }
#pragma unroll
    for (int nb = 0; nb < 4; ++nb) { const float bias = a.b_ada[n0 + 16 * nb + fr];
#pragma unroll
        for (int e = 0; e < 4; ++e) {
            __hip_atomic_store(MOD + (size_t)(16 * w + 4 * fq + e) * NMOD + n0 + 16 * nb + fr, acc[0][nb][e] + bias, __ATOMIC_RELAXED, __HIP_MEMORY_SCOPE_AGENT);
            if (w == 0 && 128 + 4 * fq + e < MODROWS) __hip_atomic_store(MOD + (size_t)(128 + 4 * fq + e) * NMOD + n0 + 16 * nb + fr, acc[1][nb][e] + bias, __ATOMIC_RELAXED, __HIP_MEMORY_SCOPE_AGENT);
        } }
    asm volatile("s_waitcnt vmcnt(0) lgkmcnt(0)" ::: "memory");
    __syncthreads();
}

__device__ __forceinline__ void row_load(f32x4 (&v)[8], const float* row, int lane) {
#pragma unroll
    for (int j = 0; j < 8; ++j) v[j] = *(const f32x4*)(row + 4 * lane + 256 * j);
}
__device__ __forceinline__ void row_load_nt(f32x4 (&v)[8], const float* row, int lane) {
#pragma unroll
    for (int j = 0; j < 8; ++j) v[j] = __builtin_nontemporal_load((const f32x4*)(row + 4 * lane + 256 * j));
}
__device__ __forceinline__ void row_load_bf16(f32x4 (&v)[8], const bf16_t* row, int lane) {
#pragma unroll
    for (int j = 0; j < 8; ++j) { const u32x2 p = __builtin_nontemporal_load((const u32x2*)(row + 4 * lane + 256 * j)); v[j] = (f32x4){bf_lo(p.x), bf_hi(p.x), bf_lo(p.y), bf_hi(p.y)}; }
}
__device__ __forceinline__ void norm_core_bf16(const f32x4 (&v)[8], const f32x4 (&g)[8], const float* sc, const float* sh, bf16_t* orow, int lane) {
    float s = 0.f;
#pragma unroll
    for (int j = 0; j < 8; ++j) s += (v[j][0] * v[j][0] + v[j][1] * v[j][1]) + (v[j][2] * v[j][2] + v[j][3] * v[j][3]);
    const float rstd = rsqrtf(wave_sum(s) * (1.0f / D) + EPS);
#pragma unroll
    for (int j = 0; j < 8; ++j) { const int c = 4 * lane + 256 * j; const f32x4 a = *(const f32x4*)(sc + c), b = *(const f32x4*)(sh + c);
        const f32x4 o = (v[j] * rstd) * g[j] * (1.0f + a) + b; u32x2 wv; wv.x = cvt_pk_bf16(o[0], o[1]); wv.y = cvt_pk_bf16(o[2], o[3]); *(u32x2*)(orow + c) = wv; }
}
constexpr int TS = 136;
__device__ __forceinline__ void mixer_prompt_pair(const Args& a, LAS unsigned char* lds, int item, int tid, const bf16_t* U, const bf16_t* V, bf16_t* YB, const float* VSS) {
    const int lane = tid & 63, w = tid >> 6, fr = lane & 15, fq = lane >> 4, half = w >> 2, hw = w & 3, htid = tid & 255;
    const int g = item & 7, ch = 2 * ((item >> 3) & 7) + half, b = item >> 6;
    const int m0 = b * SEQ + ch * 128;
    LAS bf16_t* Wc = (LAS bf16_t*)lds; LAS bf16_t* VT = (LAS bf16_t*)(lds + (1 + half) * 128 * TS * 2); LAS float* rs = (LAS float*)(lds + 3 * 128 * TS * 2) + half * 128;
    if (htid < 128) rs[htid] = rsqrtf(VSS[m0 + htid] * (1.0f / CD) + EPS);
    for (int i = tid; i < 128 * 32; i += NTHREADS) { const int t = i >> 5, s4 = (i & 31) * 4; f32x4 wv = *(const f32x4*)(a.w_sg + ((size_t)g * 128 + t) * 128 + s4);
#pragma unroll
        for (int j = 0; j < 4; ++j) if (s4 + j > t) wv[j] = 0.f;
        u32x2 o; o.x = cvt_pk_bf16(wv[0], wv[1]); o.y = cvt_pk_bf16(wv[2], wv[3]); *(LAS u32x2*)(Wc + t * TS + s4) = o; }
    __syncthreads();
#pragma unroll
    for (int it = 0; it < 8; ++it) { const int s = htid & 127, cg = (htid >> 7) + 2 * it, c0 = g * 128 + cg * 8;
        const u32x4 p = *(const u32x4*)(V + (size_t)(m0 + s) * CD + c0); const float r = rs[s];
        const f32x4 g0 = *(const f32x4*)(a.g_v + c0), g1 = *(const f32x4*)(a.g_v + c0 + 4);
        float vn[8] = {bf_lo(p.x) * r * g0[0], bf_hi(p.x) * r * g0[1], bf_lo(p.y) * r * g0[2], bf_hi(p.y) * r * g0[3], bf_lo(p.z) * r * g1[0], bf_hi(p.z) * r * g1[1], bf_lo(p.w) * r * g1[2], bf_hi(p.w) * r * g1[3]};
        if (ch == 15) { float* o = a.out + O_SGVP + ((size_t)(b * 128 + s) * 8 + g) * 128 + cg * 8; *(f32x4*)o = (f32x4){vn[0], vn[1], vn[2], vn[3]}; *(f32x4*)(o + 4) = (f32x4){vn[4], vn[5], vn[6], vn[7]}; }
#pragma unroll
        for (int j = 0; j < 8; j += 2) { const unsigned pk = cvt_pk_bf16(vn[j], vn[j + 1]); VT[(cg * 8 + j) * TS + s] = (bf16_t)(pk & 0xffffu); VT[(cg * 8 + j + 1) * TS + s] = (bf16_t)(pk >> 16); } }
    __syncthreads();
    const int wr = hw >> 1, wc = hw & 1;
    f32x4 acc[4][4];
#pragma unroll
    for (int m = 0; m < 4; ++m)
#pragma unroll
        for (int n = 0; n < 4; ++n) acc[m][n] = (f32x4){0.f, 0.f, 0.f, 0.f};
#pragma unroll
    for (int ks = 0; ks < 4; ++ks) {
        bf16x8 bf[4];
#pragma unroll
        for (int n = 0; n < 4; ++n) bf[n] = *(const LAS bf16x8*)(VT + (wc * 64 + n * 16 + fr) * TS + ks * 32 + fq * 8);
#pragma unroll
        for (int m = 0; m < 4; ++m) { const bf16x8 af = *(const LAS bf16x8*)(Wc + (wr * 64 + m * 16 + fr) * TS + ks * 32 + fq * 8);
#pragma unroll
            for (int n = 0; n < 4; ++n) acc[m][n] = __builtin_amdgcn_mfma_f32_16x16x32_bf16(bf[n], af, acc[m][n], 0, 0, 0); }
    }
#pragma unroll
    for (int m = 0; m < 4; ++m) { const int t = wr * 64 + m * 16 + fr; const float bias = a.b_sg[g * 128 + t]; u32x2 up[4];
#pragma unroll
        for (int n = 0; n < 4; ++n) up[n] = *(const u32x2*)(U + (size_t)(m0 + t) * CD + g * 128 + wc * 64 + n * 16 + 4 * fq);
#pragma unroll
        for (int n = 0; n < 4; ++n) { const size_t off = (size_t)(m0 + t) * CD + g * 128 + wc * 64 + n * 16 + 4 * fq;
            u32x2 o; o.x = cvt_pk_bf16(bf_lo(up[n].x) * (acc[m][n][0] + bias), bf_hi(up[n].x) * (acc[m][n][1] + bias)); o.y = cvt_pk_bf16(bf_lo(up[n].y) * (acc[m][n][2] + bias), bf_hi(up[n].y) * (acc[m][n][3] + bias));
            *(u32x2*)(YB + off) = o; } }
    __syncthreads();
}
__device__ __forceinline__ void mixer_sample_item(const Args& a, LAS unsigned char* lds, int bs, int tid, const bf16_t* U, const bf16_t* V, bf16_t* YB, const float* VSS) {
    const int lane = tid & 63, w = tid >> 6; const int m0 = MP + bs * DSEQ;
    LAS float* rs = (LAS float*)lds;
    if (tid < 4) rs[tid] = rsqrtf(VSS[m0 + tid] * (1.0f / CD) + EPS);
    __syncthreads();
    const int c = 2 * tid, g = c >> 7;
    float vn[4][2];
#pragma unroll
    for (int s = 0; s < 4; ++s) { const unsigned p = *(const unsigned*)(V + (size_t)(m0 + s) * CD + c); const float r = rs[s]; vn[s][0] = bf_lo(p) * r * a.g_v[c]; vn[s][1] = bf_hi(p) * r * a.g_v[c + 1];
        float* o = a.out + O_SGVS + (size_t)(bs * DSEQ + s) * CD + c; o[0] = vn[s][0]; o[1] = vn[s][1]; }
#pragma unroll
    for (int t = 0; t < 4; ++t) { float s0 = a.b_sg[g * 128 + t], s1 = s0;
#pragma unroll
        for (int s = 0; s <= t; ++s) { const float wv = a.w_sg[((size_t)g * 128 + t) * 128 + s]; s0 += wv * vn[s][0]; s1 += wv * vn[s][1]; }
        const unsigned up = *(const unsigned*)(U + (size_t)(m0 + t) * CD + c);
        *(unsigned*)(YB + (size_t)(m0 + t) * CD + c) = cvt_pk_bf16(bf_lo(up) * s0, bf_hi(up) * s1); }
    __syncthreads();
}

__global__ void __launch_bounds__(NTHREADS, 2) fwd_megakernel(Args a) {
    extern __shared__ __attribute__((aligned(16))) unsigned char lds_raw[];
    LAS unsigned char* lds = (LAS unsigned char*)lds_raw;
    const int tid = threadIdx.x, lane = tid & 63, wave = __builtin_amdgcn_readfirstlane(tid >> 6);
    const int G = gridDim.x, bx = blockIdx.x;
    const int gw = bx * 8 + wave, NGW = G * 8;
    unsigned char* ws = a.ws;
    unsigned* ctl = (unsigned*)(ws + WS_CTL);
    float* MOD = (float*)(ws + WS_MOD);
    bf16_t *WIN = (bf16_t*)(ws + WS_WIN), *WPA = (bf16_t*)(ws + WS_WPA), *WPB = (bf16_t*)(ws + WS_WPB), *WOUT = (bf16_t*)(ws + WS_WOUT), *WFI = (bf16_t*)(ws + WS_WFI), *WFO = (bf16_t*)(ws + WS_WFO);
    bf16_t *H = (bf16_t*)(ws + WS_H), *MRG = (bf16_t*)(ws + WS_MRG), *BG = (bf16_t*)(ws + WS_BG), *Z = (bf16_t*)(ws + WS_Z), *U = (bf16_t*)(ws + WS_U), *V = (bf16_t*)(ws + WS_V);
    bf16_t *GA = (bf16_t*)(ws + WS_GA), *GB = (bf16_t*)(ws + WS_GB), *YA = (bf16_t*)(ws + WS_YA), *YB = (bf16_t*)(ws + WS_YB), *ACT = (bf16_t*)(ws + WS_ACT);
    float* X = a.out + O_Y;
    bf16_t* PART5 = (bf16_t*)(ws + WS_ACT + (size_t)M * DFF * 2);
    bf16_t* PART8 = (bf16_t*)(ws + WS_H);
    bf16_t* XB = (bf16_t*)(ws + WS_ACT + (size_t)M * DFF * 2 + (size_t)P5_SPLIT * MS * D * 4);
    bf16_t* SCB = MRG;
    const int lo = a.ph_lo, hi = a.ph_hi;
    volatile LAS unsigned* MISC = (volatile LAS unsigned*)(lds + 131072 + 320);
    if (tid < 32) MISC[tid] = 0u;
    __syncthreads();
    XcdBarrier xbar = xcd_barrier_post(ctl + CW_BAR + XCD_BAR_WORDS * a.li, MISC + 8);
    if (lo < 0) cg::this_grid().sync();
#ifdef ONLY_PHASE
#define IN(k) ((k) == ONLY_PHASE)
#else
#define IN(k) (lo <= (k) && (k) < hi)
#endif
#define SEAM(k) do { if (IN(k) && IN((k) + 1)) { xcd_barrier(xbar); } } while (0)

    if (IN(0)) {
        unsigned* q = ctl + 1024 * a.li;
        if (gw < SC_ROWS) {
            const int it = gw;
            const float* cr = it < NBP ? a.c_prompt + (size_t)it * D : a.c_sample + (size_t)(it - NBP) * D;
#pragma unroll
            for (int j = 0; j < 8; ++j) { const int c = 4 * lane + 256 * j; f32x4 v = (f32x4){0.f, 0.f, 0.f, 0.f}; if (it < MODROWS) v = *(const f32x4*)(cr + c);
                const unsigned long long o = (unsigned long long)cvt_pk_bf16(siluf_(v[0]), siluf_(v[1])) | ((unsigned long long)cvt_pk_bf16(siluf_(v[2]), siluf_(v[3])) << 32);
                __hip_atomic_store((unsigned long long*)(SCB + (size_t)it * D + c), o, __ATOMIC_RELAXED, __HIP_MEMORY_SCOPE_AGENT); }
            asm volatile("s_waitcnt vmcnt(0)" ::: "memory");
            __hip_atomic_fetch_add(q + CW_SCDONE, 1u, __ATOMIC_RELAXED, __HIP_MEMORY_SCOPE_AGENT);
        }
        {
            LAS bf16_t* Te = (LAS bf16_t*)(lds + wave * 16384); constexpr int QNe = IT_TOTAL / 8;
            const int xq = (int)(xb_xcc_id() & 7u); unsigned* qc = q + CW_XQ + 64 * xq;
            int cv = 0; if (lane == 0) cv = (int)atomicAdd(qc, 2u);
            const int c = __builtin_amdgcn_readfirstlane(cv);
            if (c < QNe) { const CopyItem c0 = copy_decode(a, xq * QNe + c, WIN, WPA, WPB, WOUT, WFI, WFO), c1 = copy_decode(a, xq * QNe + c + 1, WIN, WPA, WPB, WOUT, WFI, WFO);
                f32x4 v0[16], v1[16]; copy_load(c0, v0, lane); copy_load(c1, v1, lane); copy_finish(c0, v0, Te, lane); copy_finish(c1, v1, Te, lane); }
        }
        {
            if (lane == 0) { unsigned sp = 0; while (__hip_atomic_load(q + CW_SCDONE, __ATOMIC_RELAXED, __HIP_MEMORY_SCOPE_AGENT) < (unsigned)SC_ROWS * 64u && ++sp < (1u << 22)) __builtin_amdgcn_s_sleep(1); }
            asm volatile("s_waitcnt vmcnt(0)" ::: "memory");
            __syncthreads();
            for (int it0 = bx; it0 < MOD_ITEMS + 64; it0 += G) {
                const int xg = it0 & 7, idx = it0 >> 3; if (idx >= MOD_ITEMS / 8) break; const int it = xg * (MOD_ITEMS / 8) + idx;
                mod_item(a, SCB, MOD, lds, it, tid);
                if (tid == 0) __hip_atomic_fetch_add(q + CW_MODDONE, 1u, __ATOMIC_RELAXED, __HIP_MEMORY_SCOPE_AGENT);
                __syncthreads();
            }
        }
        LAS bf16_t* T = (LAS bf16_t*)(lds + wave * 16384);
        {
            constexpr int QN = IT_TOTAL / 8;
            static_assert(IT_TOTAL % 16 == 0, "queue split");
            const int x0 = (int)(xb_xcc_id() & 7u);
            for (int qi = 0; qi < 8; ++qi) {
                const int xq = (x0 + qi) & 7; unsigned* qc = q + CW_XQ + 64 * xq;
                if ((int)__builtin_amdgcn_readfirstlane(__hip_atomic_load(qc, __ATOMIC_RELAXED, __HIP_MEMORY_SCOPE_AGENT)) >= QN) continue;
                int cv = 0; if (lane == 0) cv = (int)atomicAdd(qc, 2u);
                for (;;) {
                    const int c = __builtin_amdgcn_readfirstlane(cv);
                    if (c >= QN) break;
                    const CopyItem c0 = copy_decode(a, xq * QN + c, WIN, WPA, WPB, WOUT, WFI, WFO), c1 = copy_decode(a, xq * QN + c + 1, WIN, WPA, WPB, WOUT, WFI, WFO);
                    f32x4 v0[16], v1[16];
                    copy_load(c0, v0, lane); copy_load(c1, v1, lane);
                    cv = 0; if (lane == 0) cv = (int)atomicAdd(qc, 2u);
                    copy_finish(c0, v0, T, lane); copy_finish(c1, v1, T, lane);
                }
            }
        }
        {
            if (lane == 0) { unsigned sp = 0; while (__hip_atomic_load(q + CW_MODDONE, __ATOMIC_RELAXED, __HIP_MEMORY_SCOPE_AGENT) < (unsigned)MOD_ITEMS && ++sp < (1u << 22)) __builtin_amdgcn_s_sleep(1); }
            asm volatile("s_waitcnt vmcnt(0)" ::: "memory");
            f32x4 gv[8], v[8]; row_load(gv, a.g_mix, lane);
            if (gw < M) row_load_nt(v, gw < MP ? a.x_prompt + (size_t)gw * D : a.x_sample + (size_t)(gw - MP) * D, lane);
            for (int m = gw; m < M; m += NGW) { const int m2 = m + NGW; f32x4 nv[8];
                if (m2 < M) row_load_nt(nv, m2 < MP ? a.x_prompt + (size_t)m2 * D : a.x_sample + (size_t)(m2 - MP) * D, lane);
                const float* mr = MOD + (size_t)mod_row(m) * NMOD;
                norm_core_bf16(v, gv, mr + 1 * D, mr + 0 * D, H + (size_t)m * D, lane);
#pragma unroll
                for (int j = 0; j < 8; ++j) v[j] = nv[j]; }
        }
    }
    SEAM(1);
    if (IN(2)) {
        pg8::SchedPlain S; S.o.init(M / 256, NIN / 256, G, bx); S.A = (const char*)H; S.B = (const char*)WIN; S.tsA = (size_t)256 * D * 2; S.tsB = (size_t)256 * D * 2; S.nk = D / 64;
        pg8::EpiIn E{BG, Z, U, V, GA, GB, (float*)(ctl + CW_VSS)};
        pg8::gemm_phase(lds, D, D, S, E);
    }
    SEAM(2);
    if (IN(3)) {
        for (int it = bx; it < 256 + NBS; it += G) { if (it < 256) mixer_prompt_pair(a, lds, it, tid, U, V, YB, (const float*)(ctl + CW_VSS)); else mixer_sample_item(a, lds, it - 256, tid, U, V, YB, (const float*)(ctl + CW_VSS)); }
        for (int it = gw; it < (MP / 8) * 2; it += NGW) {
            const int r0 = (it >> 1) * 8, c = (it & 1) * 512 + lane * 8, t0 = r0 & (SEQ - 1);
            u32x4 zr[10], bgr[8];
#pragma unroll
            for (int i = 0; i < 10; ++i) { zr[i] = (u32x4){0u, 0u, 0u, 0u}; if (i >= 2 || t0 > 0) zr[i] = __builtin_nontemporal_load((const u32x4*)(Z + (size_t)(r0 - 2 + i) * CD + c)); }
#pragma unroll
            for (int i = 0; i < 8; ++i) bgr[i] = __builtin_nontemporal_load((const u32x4*)(BG + (size_t)(r0 + i) * CD + c));
            float wk[3][8];
#pragma unroll
            for (int k = 0; k < 3; ++k) { const f32x4 w0 = *(const f32x4*)(a.w_conv + k * CD + c), w1 = *(const f32x4*)(a.w_conv + k * CD + c + 4);
#pragma unroll
                for (int j = 0; j < 4; ++j) { wk[k][j] = w0[j]; wk[k][4 + j] = w1[j]; } }
#pragma unroll
            for (int i = 0; i < 8; ++i) {
                float y[8], zc[8];
#pragma unroll
                for (int j = 0; j < 4; ++j) {
                    const float z0l = bf_lo(zr[i][j]), z0h = bf_hi(zr[i][j]), z1l = bf_lo(zr[i + 1][j]), z1h = bf_hi(zr[i + 1][j]), z2l = bf_lo(zr[i + 2][j]), z2h = bf_hi(zr[i + 2][j]);
                    y[2 * j] = bf_lo(bgr[i][j]) * (wk[0][2 * j] * z0l + wk[1][2 * j] * z1l + wk[2][2 * j] * z2l);
                    y[2 * j + 1] = bf_hi(bgr[i][j]) * (wk[0][2 * j + 1] * z0h + wk[1][2 * j + 1] * z1h + wk[2][2 * j + 1] * z2h);
                    zc[2 * j] = z2l; zc[2 * j + 1] = z2h; }
                u32x4 o; o.x = cvt_pk_bf16(y[0], y[1]); o.y = cvt_pk_bf16(y[2], y[3]); o.z = cvt_pk_bf16(y[4], y[5]); o.w = cvt_pk_bf16(y[6], y[7]);
                *(u32x4*)(YA + (size_t)(r0 + i) * CD + c) = o;
                if (t0 + i >= SEQ - 2) { float* dst = a.out + O_CONVP + ((size_t)(r0 >> 11) * 2 + (t0 + i - (SEQ - 2))) * CD + c;
                    *(f32x4*)dst = (f32x4){zc[0], zc[1], zc[2], zc[3]}; *(f32x4*)(dst + 4) = (f32x4){zc[4], zc[5], zc[6], zc[7]}; }
            }
        }
        for (int idx = MP * 128 + bx * NTHREADS + tid; idx < M * 128; idx += G * NTHREADS) {
            const int r = idx >> 7, c = (idx & 127) * 8;
            int t, S_; const float* pre = nullptr;
            if (r < MP) { t = r & (SEQ - 1); S_ = SEQ; } else { t = (r - MP) & 3; S_ = DSEQ; pre = a.state_conv + (size_t)((r - MP) >> 2) * 2 * CD + c; }
            float z2[8], z1[8], z0[8];
            { const u32x4 p = *(const u32x4*)(Z + (size_t)r * CD + c); z2[0] = bf_lo(p.x); z2[1] = bf_hi(p.x); z2[2] = bf_lo(p.y); z2[3] = bf_hi(p.y); z2[4] = bf_lo(p.z); z2[5] = bf_hi(p.z); z2[6] = bf_lo(p.w); z2[7] = bf_hi(p.w); }
            if (t >= 1) { const u32x4 p = *(const u32x4*)(Z + (size_t)(r - 1) * CD + c); z1[0] = bf_lo(p.x); z1[1] = bf_hi(p.x); z1[2] = bf_lo(p.y); z1[3] = bf_hi(p.y); z1[4] = bf_lo(p.z); z1[5] = bf_hi(p.z); z1[6] = bf_lo(p.w); z1[7] = bf_hi(p.w); }
            else {
#pragma unroll
                for (int j = 0; j < 8; ++j) z1[j] = pre ? pre[CD + j] : 0.f; }
            if (t >= 2) { const u32x4 p = *(const u32x4*)(Z + (size_t)(r - 2) * CD + c); z0[0] = bf_lo(p.x); z0[1] = bf_hi(p.x); z0[2] = bf_lo(p.y); z0[3] = bf_hi(p.y); z0[4] = bf_lo(p.z); z0[5] = bf_hi(p.z); z0[6] = bf_lo(p.w); z0[7] = bf_hi(p.w); }
            else {
#pragma unroll
                for (int j = 0; j < 8; ++j) z0[j] = pre ? pre[t * CD + j] : 0.f; }
            const u32x4 bgp = *(const u32x4*)(BG + (size_t)r * CD + c);
            const float bg[8] = {bf_lo(bgp.x), bf_hi(bgp.x), bf_lo(bgp.y), bf_hi(bgp.y), bf_lo(bgp.z), bf_hi(bgp.z), bf_lo(bgp.w), bf_hi(bgp.w)};
            float y[8];
#pragma unroll
            for (int j = 0; j < 8; ++j) y[j] = bg[j] * (a.w_conv[c + j] * z0[j] + a.w_conv[CD + c + j] * z1[j] + a.w_conv[2 * CD + c + j] * z2[j]);
            u32x4 o; o.x = cvt_pk_bf16(y[0], y[1]); o.y = cvt_pk_bf16(y[2], y[3]); o.z = cvt_pk_bf16(y[4], y[5]); o.w = cvt_pk_bf16(y[6], y[7]);
            *(u32x4*)(YA + (size_t)r * CD + c) = o;
            if (t >= S_ - 2) {
                float* dst = (r < MP) ? a.out + O_CONVP + ((size_t)(r >> 11) * 2 + (t - (S_ - 2))) * CD + c : a.out + O_CONVS + ((size_t)((r - MP) >> 2) * 2 + (t - (S_ - 2))) * CD + c;
                *(f32x4*)dst = (f32x4){z2[0], z2[1], z2[2], z2[3]}; *(f32x4*)(dst + 4) = (f32x4){z2[4], z2[5], z2[6], z2[7]};
            }
        }
    }
    SEAM(3);
    if (IN(4)) {
        pg8::SchedDual S; S.o.init(M / 256, D / 256, G, bx); S.A0 = (const char*)YA; S.B0 = (const char*)WPA; S.A1 = (const char*)YB; S.B1 = (const char*)WPB; S.tsA = (size_t)256 * CD * 2; S.tsB = (size_t)256 * CD * 2; S.nk = CD / 64;
        pg8::EpiMerge E{GA, GB, MRG};
        pg8::gemm_phase(lds, CD, CD, S, E);
    }
    SEAM(4);
    if (IN(5)) {
        pg8::SchedSplit S; S.init(D / 256, P5_SPLIT, (D / 128) / P5_SPLIT, D / 64, G, bx); S.A = (const char*)MRG; S.B = (const char*)WOUT; S.tsA = (size_t)256 * D * 2; S.tsB = (size_t)256 * D * 2;
        pg8::EpiResidSplit<false> E{a.x_prompt, XB, PART5, MOD + 2 * D};
        pg8::gemm_phase(lds, D, D, S, E);
    }
    SEAM(5);
    if (IN(6)) {
        f32x4 gv[8], v[8]; row_load(gv, a.g_ffn, lane);
        const int rstep = NGW > MS ? NGW - MS : NGW; int m = (NGW > MS) ? (gw < MS ? MP + gw : gw - MS) : gw;
        if (m < M) { if (m < MP) row_load_bf16(v, XB + (size_t)m * D, lane); else row_load(v, a.x_sample + (size_t)(m - MP) * D, lane); }
        while (m < M) { int m2 = (NGW > MS) ? (m >= MP ? M : m + rstep) : m + rstep; if (NGW > MS && m2 >= MP) m2 = M; f32x4 nv[8];
            if (m2 < M) { if (m2 < MP) row_load_bf16(nv, XB + (size_t)m2 * D, lane); else row_load(nv, a.x_sample + (size_t)(m2 - MP) * D, lane); }
            if (m >= MP) {
#pragma unroll 4
                for (int q = 0; q < P5_SPLIT; ++q) {
#pragma unroll
                    for (int j = 0; j < 8; ++j) { const u32x2 p = __builtin_nontemporal_load((const u32x2*)(PART5 + ((size_t)q * MS + (m - MP)) * D + 4 * lane + 256 * j)); v[j] += (f32x4){bf_lo(p.x), bf_hi(p.x), bf_lo(p.y), bf_hi(p.y)}; } }
#pragma unroll
                for (int j = 0; j < 8; ++j) { u32x2 o; o.x = cvt_pk_bf16(v[j][0], v[j][1]); o.y = cvt_pk_bf16(v[j][2], v[j][3]); *(u32x2*)(XB + (size_t)m * D + 4 * lane + 256 * j) = o; } }
            const float* mr = MOD + (size_t)mod_row(m) * NMOD;
            norm_core_bf16(v, gv, mr + 4 * D, mr + 3 * D, H + (size_t)m * D, lane);
#pragma unroll
            for (int j = 0; j < 8; ++j) v[j] = nv[j];
            m = m2; }
    }
    SEAM(6);
    if (IN(7)) {
        pg8::SchedPlain S; S.o.init(M / 256, NFI / 256, G, bx); S.A = (const char*)H; S.B = (const char*)WFI; S.tsA = (size_t)256 * D * 2; S.tsB = (size_t)256 * D * 2; S.nk = D / 64;
        pg8::EpiSwiglu E{ACT};
        pg8::gemm_phase(lds, D, D, S, E);
    }
    SEAM(7);
    if (IN(8)) {
        pg8::SchedSplit S; S.init(D / 256, P8_SPLIT, (DFF / 128) / P8_SPLIT, DFF / 64, G, bx); S.A = (const char*)ACT; S.B = (const char*)WFO; S.tsA = (size_t)256 * DFF * 2; S.tsB = (size_t)256 * DFF * 2;
        pg8::EpiResidSplit<true> E{XB, XB, PART8, MOD + 5 * D};
        pg8::gemm_phase(lds, DFF, DFF, S, E);
    }
    SEAM(8);
    if (IN(9)) {
        f32x4 gv[8], v[8]; row_load(gv, a.g_final, lane);
        const int rstep = NGW > MS ? NGW - MS : NGW; int m = (NGW > MS) ? (gw < MS ? MP + gw : gw - MS) : gw;
        if (m < M) row_load_bf16(v, XB + (size_t)m * D, lane);
        while (m < M) { float* xr = X + (size_t)m * D; int m2 = (NGW > MS) ? (m >= MP ? M : m + rstep) : m + rstep; if (NGW > MS && m2 >= MP) m2 = M; f32x4 nv[8];
            if (m2 < M) row_load_bf16(nv, XB + (size_t)m2 * D, lane);
            if (m >= MP) {
#pragma unroll 4
                for (int q = 0; q < P8_SPLIT; ++q) {
#pragma unroll
                    for (int j = 0; j < 8; ++j) { const u32x2 p = __builtin_nontemporal_load((const u32x2*)(PART8 + ((size_t)q * MS + (m - MP)) * D + 4 * lane + 256 * j)); v[j] += (f32x4){bf_lo(p.x), bf_hi(p.x), bf_lo(p.y), bf_hi(p.y)}; } } }
            float s = 0.f;
#pragma unroll
            for (int j = 0; j < 8; ++j) s += (v[j][0] * v[j][0] + v[j][1] * v[j][1]) + (v[j][2] * v[j][2] + v[j][3] * v[j][3]);
            const float rstd = rsqrtf(wave_sum(s) * (1.0f / D) + EPS);
#pragma unroll
            for (int j = 0; j < 8; ++j) { const int c = 4 * lane + 256 * j; __builtin_nontemporal_store((v[j] * rstd) * gv[j], (f32x4*)(xr + c)); }
#pragma unroll
            for (int j = 0; j < 8; ++j) v[j] = nv[j];
            m = m2; }
    }
#undef IN
#undef SEAM
}

extern "C" void kernel_launch(void* const* d_in, const int* in_sizes, int n_in, void* d_out, int out_size, void* d_ws, size_t ws_size, hipStream_t stream) {
    static int grid = 0;
    if (grid == 0) {
        if (n_in != 20 || ws_size < WS_END) { fprintf(stderr, "kernel_launch: need 20 inputs and >= %zu bytes of workspace; got %d, %zu\n", (size_t)WS_END, n_in, ws_size); grid = -1; return; }
        int dev = 0, cus = 0, per_cu = 0;
        if (hipGetDevice(&dev) != hipSuccess || hipDeviceGetAttribute(&cus, hipDeviceAttributeMultiprocessorCount, dev) != hipSuccess) { grid = -1; return; }
        if (hipFuncSetAttribute((const void*)fwd_megakernel, hipFuncAttributeMaxDynamicSharedMemorySize, LDS_BYTES) != hipSuccess) { fprintf(stderr, "kernel_launch: hipFuncSetAttribute failed\n"); grid = -1; return; }
        if (hipOccupancyMaxActiveBlocksPerMultiprocessor(&per_cu, (const void*)fwd_megakernel, NTHREADS, LDS_BYTES) != hipSuccess || per_cu < 1) { fprintf(stderr, "kernel_launch: occupancy query reports %d blocks per CU\n", per_cu); grid = -1; return; }
        grid = cus * 1;
    }
    if (grid < 0) return;
    hipMemsetAsync((char*)d_ws + WS_CTL, 0, CTL_BYTES, stream);
    Args a{};
    a.x_prompt = (const float*)d_in[0]; a.x_sample = (const float*)d_in[1]; a.state_conv = (const float*)d_in[2]; a.c_prompt = (const float*)d_in[3]; a.c_sample = (const float*)d_in[4];
    a.g_mix = (const float*)d_in[5]; a.g_ffn = (const float*)d_in[6]; a.w_ada = (const float*)d_in[7]; a.b_ada = (const float*)d_in[8]; a.w_in = (const float*)d_in[9]; a.w_conv = (const float*)d_in[10];
    a.g_v = (const float*)d_in[11]; a.w_sg = (const float*)d_in[12]; a.b_sg = (const float*)d_in[13]; a.w_pa = (const float*)d_in[14]; a.w_pb = (const float*)d_in[15]; a.w_out = (const float*)d_in[16];
    a.w_ffn_in = (const float*)d_in[17]; a.w_ffn_out = (const float*)d_in[18]; a.g_final = (const float*)d_in[19];
    a.out = (float*)d_out; a.ws = (unsigned char*)d_ws;
#if MK_N_LAUNCHES == 1
    if (PROBE_PHASE < 0) {
        a.ph_lo = 0; a.ph_hi = NPHASE; a.li = 0;
        void* args[] = {&a};
        hipError_t e = hipLaunchCooperativeKernel((const void*)fwd_megakernel, dim3(grid), dim3(NTHREADS), args, LDS_BYTES, stream);
        if (e != hipSuccess) fprintf(stderr, "kernel_launch: cooperative launch failed: %s (grid %d)\n", hipGetErrorString(e), grid);
    } else {
        const int cuts[4] = {0, PROBE_PHASE + 1, PROBE_PHASE + 1, NPHASE};
        for (int li = 0; li < 3; ++li) { a.ph_lo = (li == 1) ? PROBE_PHASE : cuts[li]; a.ph_hi = cuts[li + 1]; a.li = li; if (a.ph_lo >= a.ph_hi) continue;
            void* args[] = {&a};
            hipError_t e = hipLaunchCooperativeKernel((const void*)fwd_megakernel, dim3(grid), dim3(NTHREADS), args, LDS_BYTES, stream);
            if (e != hipSuccess) fprintf(stderr, "kernel_launch: cooperative launch failed: %s (grid %d)\n", hipGetErrorString(e), grid); }
    }
#else
    for (int p = 0; p < NPHASE; ++p) { a.ph_lo = p; a.ph_hi = p + 1; a.li = 0; hipLaunchKernelGGL(fwd_megakernel, dim3(grid), dim3(NTHREADS), LDS_BYTES, stream, a); }
#endif
}
```

```cpp
#include <hip/hip_runtime.h>
#include <hip/hip_cooperative_groups.h>
#include <cstdio>
#include <cstdint>
namespace cg = cooperative_groups;

#define LAS __attribute__((address_space(3)))
typedef unsigned short bf16_t;
typedef short bf16x8 __attribute__((ext_vector_type(8)));
typedef float f32x4 __attribute__((ext_vector_type(4)));
typedef unsigned u32x4 __attribute__((ext_vector_type(4)));
typedef unsigned u32x2 __attribute__((ext_vector_type(2)));

#define PROBE_PHASE -1
#ifndef MK_N_LAUNCHES
#define MK_N_LAUNCHES 1
#endif

constexpr int D = 2048, MP = 8192, MS = 512, M = MP + MS, SEQ = 2048, NBP = 4, NBS = 128, DSEQ = 4;
constexpr int CD = 1024, NIN = 9216, DFF = 5632, NFI = 2 * DFF, NMOD = 6 * D, MODROWS = NBP + NBS;
constexpr float EPS = 1e-6f;
constexpr int NPHASE = 10;
constexpr int P5_SPLIT = 8, P8_SPLIT = 11;
constexpr size_t O_Y = 0, O_CONVP = (size_t)M * D, O_CONVS = O_CONVP + (size_t)NBP * 2 * CD, O_SGVP = O_CONVS + (size_t)NBS * 2 * CD, O_SGVS = O_SGVP + (size_t)NBP * 128 * 1024;
constexpr size_t al4k(size_t x) { return (x + 4095) & ~(size_t)4095; }
constexpr size_t WS_CTL = 0, CTL_BYTES = 131072;
constexpr size_t WS_MOD = 131072;
constexpr int CW_BAR = 4096, CW_VSS = 16384;
constexpr size_t WS_WIN = al4k(WS_MOD + (size_t)MODROWS * NMOD * 4);
constexpr size_t WS_WPA = al4k(WS_WIN + (size_t)NIN * D * 2);
constexpr size_t WS_WPB = al4k(WS_WPA + (size_t)D * CD * 2);
constexpr size_t WS_WOUT = al4k(WS_WPB + (size_t)D * CD * 2);
constexpr size_t WS_WFI = al4k(WS_WOUT + (size_t)D * D * 2);
constexpr size_t WS_WFO = al4k(WS_WFI + (size_t)NFI * D * 2);
constexpr size_t WS_H = al4k(WS_WFO + (size_t)D * DFF * 2);
constexpr size_t WS_MRG = al4k(WS_H + (size_t)M * D * 2);
constexpr size_t WS_R1 = al4k(WS_MRG + (size_t)M * D * 2);
constexpr size_t WS_BG = WS_R1;
constexpr size_t WS_Z = WS_BG + (size_t)M * CD * 2;
constexpr size_t WS_U = WS_Z + (size_t)M * CD * 2;
constexpr size_t WS_V = WS_U + (size_t)M * CD * 2;
constexpr size_t WS_GA = WS_V + (size_t)M * CD * 2;
constexpr size_t WS_GB = WS_GA + (size_t)M * D * 2;
constexpr size_t WS_YA = WS_GB + (size_t)M * D * 2;
constexpr size_t WS_YB = WS_YA + (size_t)M * CD * 2;
constexpr size_t WS_R1_END = WS_YB + (size_t)M * CD * 2;
constexpr size_t WS_ACT = WS_R1;
constexpr size_t WS_END = (WS_R1_END > WS_ACT + (size_t)M * DFF * 2) ? WS_R1_END : WS_ACT + (size_t)M * DFF * 2;
static_assert(WS_ACT + (size_t)M * DFF * 2 + (size_t)P5_SPLIT * MS * D * 4 + (size_t)M * D * 2 <= WS_R1_END, "ACT + PART5 + XB overlay fits");
static_assert(WS_MRG == WS_H + (size_t)M * D * 2 && WS_R1 >= WS_H + (size_t)P8_SPLIT * MS * D * 4, "PART8 overlay fits");
static_assert((D / 128) % P5_SPLIT == 0 && (DFF / 128) % P8_SPLIT == 0 && 16 * P5_SPLIT <= 256 && 16 * P8_SPLIT <= 256, "piece geometry");

constexpr int LDS_BYTES = 147456;
constexpr int NTHREADS = 512;

__device__ __forceinline__ unsigned cvt_pk_bf16(float lo, float hi) { unsigned r; asm volatile("v_cvt_pk_bf16_f32 %0, %1, %2" : "=v"(r) : "v"(lo), "v"(hi)); return r; }
__device__ __forceinline__ float bf_lo(unsigned w) { return __uint_as_float(w << 16); }
__device__ __forceinline__ float bf_hi(unsigned w) { return __uint_as_float(w & 0xffff0000u); }
__device__ __forceinline__ float sigmoidf_(float x) { return __builtin_amdgcn_rcpf(1.0f + __expf(-x)); }
__device__ __forceinline__ float siluf_(float x) { return x * sigmoidf_(x); }
__device__ __forceinline__ float gelu_tanh(float x) { return x * sigmoidf_(1.5957691216057308f * (x + 0.044715f * x * x * x)); }
__device__ __forceinline__ float wave_sum(float v) {
#pragma unroll
    for (int o = 1; o < 64; o <<= 1) v += __shfl_xor(v, o);
    return v;
}
__device__ __forceinline__ int mod_row(int r) { return r < MP ? (r >> 11) : NBP + ((r - MP) >> 2); }


#define XB_TMO      128
#define XB_XCNT(j)  (256  + 64 * (j))
#define XB_XSUB(j)  (1280 + 64 * (j))
#define XB_XGEN(j)  (2304 + 64 * (j))
#define XB_TOP      3328
#define XB_TOPGEN   3392
#define XCD_BAR_WORDS 3456
#define XB_SPIN_CAP (1u << 18)
__device__ __forceinline__ unsigned xb_ld(unsigned* p)              { return __hip_atomic_load(p, __ATOMIC_RELAXED, __HIP_MEMORY_SCOPE_AGENT); }
__device__ __forceinline__ unsigned xb_add(unsigned* p, unsigned v) { return __hip_atomic_fetch_add(p, v, __ATOMIC_RELAXED, __HIP_MEMORY_SCOPE_AGENT); }
__device__ __forceinline__ unsigned xb_xcc_id() { return (unsigned)__builtin_amdgcn_s_getreg((3 << 11) | 20) & 0xFu; }
#define XB_SPIN(cond, bar) do { unsigned _sp = 0; while (cond) { __builtin_amdgcn_s_sleep(1); \
    if ((++_sp & 255u) == 0u) { if (xb_ld(&(bar)[XB_TMO])) break; if (_sp > XB_SPIN_CAP) { atomicAdd(&(bar)[XB_TMO], 1u); break; } } } } while (0)
struct XcdBarrier { unsigned* bar; unsigned x; volatile LAS unsigned* st; };
__device__ __forceinline__ XcdBarrier xcd_barrier_post(unsigned* bar, volatile LAS unsigned* st) {
    XcdBarrier b; b.bar = bar; b.x = xb_xcc_id(); b.st = st;
    if (threadIdx.x == 0) (void)xb_add(&bar[XB_XCNT(b.x)], 1u);
    return b;
}
__device__ __forceinline__ void xcd_barrier_complete(unsigned* bar, unsigned x, unsigned& nloc, unsigned& nx) {
    const unsigned G = gridDim.x * gridDim.y * gridDim.z;
    unsigned sum, cnt, mine, sp = 0u;
    for (;;) {
        sum = 0u; cnt = 0u; mine = 0u;
#pragma unroll
        for (unsigned j = 0; j < 16; ++j) { const unsigned c = xb_ld(&bar[XB_XCNT(j)]); sum += c; cnt += (c > 0u) ? 1u : 0u; mine = (j == x) ? c : mine; }
        if (sum == G) break;
        __builtin_amdgcn_s_sleep(1);
        if ((++sp & 255u) == 0u) { if (xb_ld(&bar[XB_TMO])) break; if (sp > XB_SPIN_CAP) { atomicAdd(&bar[XB_TMO], 1u); break; } }
    }
    nloc = mine > 0u ? mine : 1u; nx = cnt > 0u ? cnt : 1u;
}
__device__ __forceinline__ void xcd_barrier(const XcdBarrier& b) {
    asm volatile("s_waitcnt vmcnt(0)" ::: "memory");
    __syncthreads();
    if (threadIdx.x == 0) {
        unsigned* bar = b.bar;
        __builtin_amdgcn_s_waitcnt(0);
        unsigned nloc = b.st[0], nx = b.st[1];
        if (nloc == 0u) { xcd_barrier_complete(bar, b.x, nloc, nx); b.st[0] = nloc; b.st[1] = nx; }
        const unsigned old = xb_add(&bar[XB_XSUB(b.x)], 1u);
        const unsigned gen = old / nloc;
        if (old + 1u == (gen + 1u) * nloc) {
            __builtin_amdgcn_fence(__ATOMIC_RELEASE, "agent");
            asm volatile("s_waitcnt vmcnt(0)" ::: "memory");
            const unsigned og = xb_add(&bar[XB_TOP], 1u);
            const unsigned tg = og / nx;
            if (og + 1u == (tg + 1u) * nx) xb_add(&bar[XB_TOPGEN], 1u);
            else XB_SPIN(xb_ld(&bar[XB_TOPGEN]) == tg, bar);
            __builtin_amdgcn_fence(__ATOMIC_ACQUIRE, "agent");
            xb_add(&bar[XB_XGEN(b.x)], 1u);
            asm volatile("s_waitcnt vmcnt(0)" ::: "memory");
        } else {
            XB_SPIN(xb_ld(&bar[XB_XGEN(b.x)]) == gen, bar);
            __builtin_amdgcn_fence(__ATOMIC_ACQUIRE, "agent");
            asm volatile("s_waitcnt vmcnt(0)" ::: "memory");
        }
    }
    __syncthreads();
}

namespace pg8 {
constexpr int BM = 256, BK = 64, HALF = 128, HTB = HALF * BK * 2, STAGE_BYTES = 8 * HTB, NXCD = 8, WGM = 8;
__host__ __device__ __forceinline__ int lds_byte(int r, int c) { const int st = (r >> 4) * 2 + (c >> 5), rr = r & 15, cc = c & 31, ob = rr * 64 + cc * 2; return st * 1024 + (ob ^ (((ob >> 9) & 1) << 5)); }
__host__ __device__ __forceinline__ void stage_rc(int b, int& R, int& C) { const int st = b / 1024, sb = b % 1024, swz = sb ^ (((sb >> 9) & 1) << 5); R = (st >> 1) * 16 + swz / 64; C = (st & 1) * 32 + (swz % 64) / 2; }
__host__ __device__ __forceinline__ int perm32(int rho) { const int n = rho >> 4, i = rho & 15; return 8 * (i >> 2) + 4 * n + (i & 3); }

struct Unit { const char* A; const char* B; int nk, pm, pn, aux, keep; };

struct TileOrder {
    int nM, nN, nwg, G, c;
    __device__ void init(int nM_, int nN_, int G_, int c_) { nM = nM_; nN = nN_; nwg = nM * nN; G = G_; c = c_; }
    __device__ bool tile(int i, int& pm, int& pn) const {
        const long L = (long)i * G + c; if (L >= nwg) return false;
        int wgid = (int)L; { const int q = nwg / NXCD, r = nwg % NXCD, xcd = wgid % NXCD, off = wgid / NXCD; wgid = (xcd < r ? xcd * (q + 1) : r * (q + 1) + (xcd - r) * q) + off; }
        const int nig = WGM * nN, gid = wgid / nig, fm = gid * WGM, gsz = (nM - fm) < WGM ? (nM - fm) : WGM;
        pm = fm + ((wgid % nig) % gsz); pn = (wgid % nig) / gsz; return true;
    }
};
struct SchedPlain {
    TileOrder o; const char* A; const char* B; size_t tsA, tsB; int nk;
    __device__ bool next(int i, Unit& u) const { int pm, pn; if (!o.tile(i, pm, pn)) return false; u.A = A + (size_t)pm * tsA; u.B = B + (size_t)pn * tsB; u.nk = nk; u.pm = pm; u.pn = pn; u.aux = 0; u.keep = 0; return true; }
};
struct SchedDual {
    TileOrder o; const char* A0; const char* B0; const char* A1; const char* B1; size_t tsA, tsB; int nk;
    __device__ bool next(int i, Unit& u) const { int pm, pn; if (!o.tile(i >> 1, pm, pn)) return false; const int s = i & 1;
        u.A = (s ? A1 : A0) + (size_t)pm * tsA; u.B = (s ? B1 : B0) + (size_t)pn * tsB; u.nk = nk; u.pm = pm; u.pn = pn; u.aux = s; u.keep = !s; return true; }
};

struct SchedSplit {
    TileOrder o; int S, PP, G, c; const char* A; const char* B; size_t tsA, tsB; int nkfull;
    __device__ void init(int nN, int S_, int PP_, int nkfull_, int G_, int c_) { o.init(MP / 256, nN, G_, c_); S = S_; PP = PP_; G = G_; c = c_; nkfull = nkfull_; }
    __device__ bool next(int i, Unit& u) const {
        const int R = (o.nwg - c + G - 1) / G;
        if (i < R) { int pm, pn; o.tile(i, pm, pn); u.A = A + (size_t)pm * tsA; u.B = B + (size_t)pn * tsB; u.nk = nkfull; u.pm = pm; u.pn = pn; u.aux = 0; u.keep = 0; return true; }
        const int idx = c + (i - R) * G; if (idx >= 2 * o.nN * S) return false;
        const int j = idx / S, sp = idx % S; u.pm = MP / 256 + j / o.nN; u.pn = j % o.nN;
        u.A = A + (size_t)u.pm * tsA + (size_t)sp * PP * 256; u.B = B + (size_t)u.pn * tsB + (size_t)sp * PP * 256; u.nk = 2 * PP; u.aux = 1 + sp; u.keep = 0; return true;
    }
};

template <class Epi, class Sched>
__device__ __forceinline__ void gemm_phase(LAS unsigned char* lds, int lda, int ldb, const Sched& S, const Epi& E) {
    const int tid = threadIdx.x, wid = __builtin_amdgcn_readfirstlane(tid >> 6), lane = tid & 63, wr = wid >> 2, wc = wid & 3, fr = lane & 15, fq = lane >> 4;
    unsigned voffA[2], voffB[2];
#pragma unroll
    for (int i = 0; i < 2; ++i) { int R, C; stage_rc(tid * 16 + i * 8192, R, C); const int Rb = Epi::PERM ? ((R & ~31) + perm32(R & 31)) : R;
        voffA[i] = (unsigned)(R * lda + C) * 2u; voffB[i] = (unsigned)(Rb * ldb + C) * 2u; }
    const size_t kstep = (size_t)(BK * 2);
    const size_t hstepA = (size_t)HALF * lda * 2, hstepB = (size_t)HALF * ldb * 2;
    const unsigned ldsw = (unsigned)wid * 1024u;
    const int aoff = lds_byte(wr * 64 + fr, fq * 8), boff = lds_byte(wc * 32 + fr, fq * 8);
#define PG8_SA(b, h) (((b) * 2 + (h)) * HTB)
#define PG8_SB(b, h) ((4 + (b) * 2 + (h)) * HTB)
#define PG8_STAGE(bufoff, gbase, voff) do { _Pragma("unroll") for (int _i = 0; _i < 2; ++_i) \
        __builtin_amdgcn_global_load_lds((const unsigned*)((const char*)(gbase) + (voff)[_i]), (LAS unsigned*)(lds + (bufoff) + ldsw + _i * 8192), 16, 0, 0); } while (0)
#define PG8_LDA(dst, b, h) do { _Pragma("unroll") for (int m = 0; m < 4; ++m) _Pragma("unroll") for (int k = 0; k < 2; ++k) dst[m][k] = *(const LAS bf16x8*)(lds + PG8_SA(b, h) + aoff + m * 2048 + k * 1024); } while (0)
#define PG8_LDB(dst, b, h) do { _Pragma("unroll") for (int n = 0; n < 2; ++n) _Pragma("unroll") for (int k = 0; k < 2; ++k) dst[n][k] = *(const LAS bf16x8*)(lds + PG8_SB(b, h) + boff + n * 2048 + k * 1024); } while (0)
#define PG8_MMA(ai, bj, At, Bt) do { __builtin_amdgcn_s_setprio(1); _Pragma("unroll") for (int m = 0; m < 4; ++m) _Pragma("unroll") for (int n = 0; n < 2; ++n) _Pragma("unroll") for (int k = 0; k < 2; ++k) \
        acc[ai][bj][m][n] = __builtin_amdgcn_mfma_f32_16x16x32_bf16(Bt[n][k], At[m][k], acc[ai][bj][m][n], 0, 0, 0); __builtin_amdgcn_s_setprio(0); } while (0)
#define PG8_WAIT_V(n) asm volatile("s_waitcnt vmcnt(" #n ")" ::: "memory")
#define PG8_WAIT_L(n) asm volatile("s_waitcnt lgkmcnt(" #n ")" ::: "memory")
#define PG8_BAR __builtin_amdgcn_s_barrier()
#define PG8_SCHED __builtin_amdgcn_sched_barrier(0)
    Unit cur, nxt; int ui = 0;
    if (!S.next(0, cur)) return;
    f32x4 acc[2][2][4][2];
#pragma unroll
    for (int a = 0; a < 2; ++a)
#pragma unroll
        for (int b = 0; b < 2; ++b)
#pragma unroll
            for (int m = 0; m < 4; ++m)
#pragma unroll
                for (int n = 0; n < 2; ++n) acc[a][b][m][n] = (f32x4){0.f, 0.f, 0.f, 0.f};
    bf16x8 At[4][2], B0[2][2], B1[2][2];
    const char* cA = cur.A; const char* cB = cur.B;
    PG8_STAGE(PG8_SB(0, 0), cB, voffB); PG8_STAGE(PG8_SB(0, 1), cB + hstepB, voffB); PG8_STAGE(PG8_SA(0, 0), cA, voffA); PG8_STAGE(PG8_SA(0, 1), cA + hstepA, voffA);
    if (wr == 1) PG8_BAR;
    PG8_WAIT_V(2); PG8_BAR;
    PG8_STAGE(PG8_SB(1, 0), cB + kstep, voffB); PG8_STAGE(PG8_SA(1, 0), cA + kstep, voffA); PG8_STAGE(PG8_SB(1, 1), cB + hstepB + kstep, voffB);
    PG8_WAIT_V(6); PG8_BAR;
    for (;;) {
        const bool has_next = S.next(ui + 1, nxt);
        const char* nA = has_next ? nxt.A : cA; const char* nB = has_next ? nxt.B : cB;
        const int nt = cur.nk;
        for (int t = 0; t < nt; t += 2) {
            const bool last = (t == nt - 2);
            const char* a1 = cA + (size_t)(t + 1) * kstep;
            const char* a2 = last ? nA : cA + (size_t)(t + 2) * kstep; const char* b2 = last ? nB : cB + (size_t)(t + 2) * kstep;
            const char* a3 = a2 + kstep; const char* b3 = b2 + kstep;
            PG8_LDB(B0, 0, 0); PG8_LDB(B1, 0, 1); PG8_SCHED; PG8_LDA(At, 0, 0); PG8_STAGE(PG8_SA(1, 1), a1 + hstepA, voffA);
            PG8_WAIT_V(8); PG8_WAIT_L(0); PG8_BAR; PG8_MMA(0, 0, At, B0); PG8_MMA(0, 1, At, B1); PG8_BAR; PG8_SCHED;
            PG8_LDA(At, 0, 1); PG8_STAGE(PG8_SB(0, 0), b2, voffB); PG8_STAGE(PG8_SB(0, 1), b2 + hstepB, voffB); PG8_STAGE(PG8_SA(0, 0), a2, voffA);
            PG8_WAIT_V(8); PG8_WAIT_L(0); PG8_BAR; PG8_MMA(1, 0, At, B0); PG8_MMA(1, 1, At, B1); PG8_BAR; PG8_SCHED;
            PG8_LDB(B0, 1, 0); PG8_LDB(B1, 1, 1); PG8_SCHED; PG8_LDA(At, 1, 0); PG8_STAGE(PG8_SA(0, 1), a2 + hstepA, voffA);
            PG8_WAIT_V(8); PG8_WAIT_L(0); PG8_BAR; PG8_MMA(0, 0, At, B0); PG8_MMA(0, 1, At, B1); PG8_BAR; PG8_SCHED;
            PG8_LDA(At, 1, 1); PG8_STAGE(PG8_SB(1, 0), b3, voffB); PG8_STAGE(PG8_SB(1, 1), b3 + hstepB, voffB); PG8_STAGE(PG8_SA(1, 0), a3, voffA);
            PG8_WAIT_V(8); PG8_WAIT_L(0); PG8_BAR; PG8_MMA(1, 0, At, B0); PG8_MMA(1, 1, At, B1); PG8_BAR; PG8_SCHED;
        }
        if (wr == 0) PG8_BAR;
        E(acc, cur, wr, wc, fr, fq);
        if (!has_next) break;
        if (!cur.keep) {
#pragma unroll
            for (int a = 0; a < 2; ++a)
#pragma unroll
                for (int b = 0; b < 2; ++b)
#pragma unroll
                    for (int m = 0; m < 4; ++m)
#pragma unroll
                        for (int n = 0; n < 2; ++n) acc[a][b][m][n] = (f32x4){0.f, 0.f, 0.f, 0.f};
        }
        cur = nxt; cA = nA; cB = nB; ++ui;
        if (wr == 1) PG8_BAR;
    }
    PG8_WAIT_V(0);
    PG8_BAR;
#undef PG8_SA
#undef PG8_SB
#undef PG8_STAGE
#undef PG8_LDA
#undef PG8_LDB
#undef PG8_MMA
#undef PG8_WAIT_V
#undef PG8_WAIT_L
#undef PG8_BAR
#undef PG8_SCHED
}

__device__ __forceinline__ void st8(bf16_t* p, f32x4 v0, f32x4 v1) {
    u32x4 w; w.x = cvt_pk_bf16(v0[0], v0[1]); w.y = cvt_pk_bf16(v0[2], v0[3]); w.z = cvt_pk_bf16(v1[0], v1[1]); w.w = cvt_pk_bf16(v1[2], v1[3]);
    *(u32x4*)p = w;
}
template <int ACT> __device__ __forceinline__ f32x4 act4(f32x4 v) {
    if (ACT == 1) { return (f32x4){gelu_tanh(v[0]), gelu_tanh(v[1]), gelu_tanh(v[2]), gelu_tanh(v[3])}; }
    if (ACT == 2) { return (f32x4){sigmoidf_(v[0]), sigmoidf_(v[1]), sigmoidf_(v[2]), sigmoidf_(v[3])}; }
    return v;
}
struct EpiIn {
    static constexpr bool PERM = true;
    bf16_t *BG, *Z, *U, *V, *GA, *GB; float* VSS;
    __device__ __forceinline__ void operator()(f32x4 (&acc)[2][2][4][2], const Unit& u, int wr, int wc, int fr, int fq) const {
        const int row0 = u.pm * BM + wr * 64 + fr, cl = wc * 32 + 8 * fq, pn = u.pn;
        bf16_t* dst; int ld, mode, coff;
        if (pn < 4) { dst = BG; ld = CD; mode = 0; coff = pn * 256; }
        else if (pn < 12) { dst = Z; ld = CD; mode = 3; coff = (pn - 4) * 128; }
        else if (pn < 16) { dst = U; ld = CD; mode = 1; coff = (pn - 12) * 256; }
        else if (pn < 20) { dst = V; ld = CD; mode = 1; coff = (pn - 16) * 256; }
        else { dst = GA; ld = D; mode = 4; coff = (pn - 20) * 128; }
        bf16_t* base = dst + (size_t)row0 * ld + coff + cl; const bool isv = (pn >= 16 && pn < 20);
        if (mode == 4) {
            bf16_t* base2 = GB + (size_t)row0 * ld + coff + cl;
#pragma unroll
            for (int ai = 0; ai < 2; ++ai)
#pragma unroll
                for (int m = 0; m < 4; ++m) { const f32x4 a0 = act4<2>(acc[ai][0][m][0]), a1 = act4<2>(acc[ai][0][m][1]), b0 = act4<2>(acc[ai][1][m][0]), b1 = act4<2>(acc[ai][1][m][1]); f32x4 r0, r1;
#pragma unroll
                    for (int j = 0; j < 4; ++j) { r0[j] = a0[j] * __builtin_amdgcn_rcpf(fmaxf(b0[j], 1e-20f)); r1[j] = a1[j] * __builtin_amdgcn_rcpf(fmaxf(b1[j], 1e-20f)); }
                    st8(base + (size_t)(ai * HALF + m * 16) * ld, r0, r1); st8(base2 + (size_t)(ai * HALF + m * 16) * ld, b0, b1); asm volatile("" ::: "memory"); }
        } else if (mode == 3) {
#pragma unroll
            for (int ai = 0; ai < 2; ++ai)
#pragma unroll
                for (int m = 0; m < 4; ++m) { st8(base + (size_t)(ai * HALF + m * 16) * ld, acc[ai][0][m][0] * acc[ai][1][m][0], acc[ai][0][m][1] * acc[ai][1][m][1]); asm volatile("" ::: "memory"); }
        } else {
#pragma unroll
            for (int ai = 0; ai < 2; ++ai)
#pragma unroll
                for (int m = 0; m < 4; ++m) { bf16_t* rowp = base + (size_t)(ai * HALF + m * 16) * ld; float ss = 0.f;
#pragma unroll
                    for (int bj = 0; bj < 2; ++bj) { f32x4 v0 = acc[ai][bj][m][0], v1 = acc[ai][bj][m][1];
                        if (mode == 1) { v0 = act4<1>(v0); v1 = act4<1>(v1); } else if (mode == 2) { v0 = act4<2>(v0); v1 = act4<2>(v1); }
                        st8(rowp + bj * HALF, v0, v1);
                        if (isv) ss += (v0[0] * v0[0] + v0[1] * v0[1]) + (v0[2] * v0[2] + v0[3] * v0[3]) + (v1[0] * v1[0] + v1[1] * v1[1]) + (v1[2] * v1[2] + v1[3] * v1[3]); }
                    if (isv) { ss += __shfl_xor(ss, 16); ss += __shfl_xor(ss, 32); if (fq == 0) __hip_atomic_fetch_add(VSS + row0 + ai * HALF + m * 16, ss, __ATOMIC_RELAXED, __HIP_MEMORY_SCOPE_AGENT); }
                    asm volatile("" ::: "memory"); }
        }
    }
};
struct EpiMerge {
    static constexpr bool PERM = true;
    const bf16_t *GA, *GB; bf16_t* MRG;
    __device__ __forceinline__ void operator()(f32x4 (&acc)[2][2][4][2], const Unit& u, int wr, int wc, int fr, int fq) const {
        const int row0 = u.pm * BM + wr * 64 + fr, col0 = u.pn * BM + wc * 32 + 8 * fq;
        if (u.aux == 0) {
#pragma unroll
            for (int ai = 0; ai < 2; ++ai)
#pragma unroll
                for (int m = 0; m < 4; ++m) { const size_t off = (size_t)(row0 + ai * HALF + m * 16) * D + col0;
#pragma unroll
                    for (int bj = 0; bj < 2; ++bj) {
                        const u32x4 ga = *(const u32x4*)(GA + off + bj * HALF);
                        acc[ai][bj][m][0] *= (f32x4){bf_lo(ga.x), bf_hi(ga.x), bf_lo(ga.y), bf_hi(ga.y)}; acc[ai][bj][m][1] *= (f32x4){bf_lo(ga.z), bf_hi(ga.z), bf_lo(ga.w), bf_hi(ga.w)};
                    } }
        } else {
            u32x4 cgb[2];
#pragma unroll
            for (int bj = 0; bj < 2; ++bj) cgb[bj] = *(const u32x4*)(GB + (size_t)row0 * D + col0 + bj * HALF);
#pragma unroll
            for (int ai = 0; ai < 2; ++ai)
#pragma unroll
                for (int m = 0; m < 4; ++m) { const size_t off = (size_t)(row0 + ai * HALF + m * 16) * D + col0;
                    u32x4 ngb[2];
                    if (ai * 4 + m < 7) { const int g2 = ai * 4 + m + 1; const size_t off2 = (size_t)(row0 + (g2 >> 2) * HALF + (g2 & 3) * 16) * D + col0;
#pragma unroll
                        for (int bj = 0; bj < 2; ++bj) ngb[bj] = *(const u32x4*)(GB + off2 + bj * HALF); }
#pragma unroll
                    for (int bj = 0; bj < 2; ++bj) { const u32x4 gb = cgb[bj];
                        f32x4 b0 = (f32x4){bf_lo(gb.x), bf_hi(gb.x), bf_lo(gb.y), bf_hi(gb.y)}, b1 = (f32x4){bf_lo(gb.z), bf_hi(gb.z), bf_lo(gb.w), bf_hi(gb.w)};
#pragma unroll
                        for (int j = 0; j < 4; ++j) { b0[j] = fmaxf(b0[j], 1e-20f); b1[j] = fmaxf(b1[j], 1e-20f); }
                        st8(MRG + off + bj * HALF, acc[ai][bj][m][0] * b0, acc[ai][bj][m][1] * b1); }
#pragma unroll
                    for (int bj = 0; bj < 2; ++bj) cgb[bj] = ngb[bj];
                }
        }
    }
};
template <bool BASE_BF16> struct EpiResidSplit {
    static constexpr bool PERM = true;
    const void* base; bf16_t* XB; bf16_t* PART; const float* gate;
    __device__ __forceinline__ void ld_base(int r, int col0, f32x4 (&b)[2][2]) const {
#pragma unroll
        for (int bj = 0; bj < 2; ++bj) {
            if (BASE_BF16) { const u32x4 p = *(const u32x4*)((const bf16_t*)base + (size_t)r * D + col0 + bj * HALF); b[bj][0] = (f32x4){bf_lo(p.x), bf_hi(p.x), bf_lo(p.y), bf_hi(p.y)}; b[bj][1] = (f32x4){bf_lo(p.z), bf_hi(p.z), bf_lo(p.w), bf_hi(p.w)}; }
            else { const float* bp = (const float*)base + (size_t)r * D + col0 + bj * HALF; b[bj][0] = __builtin_nontemporal_load((const f32x4*)bp); b[bj][1] = __builtin_nontemporal_load((const f32x4*)(bp + 4)); } }
    }
    __device__ __forceinline__ void ld_gate(int r, int col0, f32x4 (&g)[2][2]) const {
        const float* gp = gate + (size_t)mod_row(r) * NMOD + col0;
#pragma unroll
        for (int bj = 0; bj < 2; ++bj) { g[bj][0] = *(const f32x4*)(gp + bj * HALF); g[bj][1] = *(const f32x4*)(gp + bj * HALF + 4); }
    }
    __device__ __forceinline__ void operator()(f32x4 (&acc)[2][2][4][2], const Unit& u, int wr, int wc, int fr, int fq) const {
        const int row0 = u.pm * BM + wr * 64 + fr, col0 = u.pn * BM + wc * 32 + 8 * fq;
        if (u.aux == 0) {
            f32x4 gt[2][2], cb[2][2];
            ld_gate(row0, col0, gt); ld_base(row0, col0, cb);
#pragma unroll
            for (int ai = 0; ai < 2; ++ai)
#pragma unroll
                for (int m = 0; m < 4; ++m) { const int r = row0 + ai * HALF + m * 16; f32x4 nb[2][2];
                    if (ai * 4 + m < 7) { const int g2 = ai * 4 + m + 1; ld_base(row0 + (g2 >> 2) * HALF + (g2 & 3) * 16, col0, nb); }
                    bf16_t* op = XB + (size_t)r * D + col0;
#pragma unroll
                    for (int bj = 0; bj < 2; ++bj) st8(op + bj * HALF, cb[bj][0] + gt[bj][0] * acc[ai][bj][m][0], cb[bj][1] + gt[bj][1] * acc[ai][bj][m][1]);
#pragma unroll
                    for (int bj = 0; bj < 2; ++bj)
#pragma unroll
                        for (int n = 0; n < 2; ++n) cb[bj][n] = nb[bj][n];
                }
        } else {
            f32x4 cg[2][2];
            ld_gate(row0, col0, cg);
#pragma unroll
            for (int ai = 0; ai < 2; ++ai)
#pragma unroll
                for (int m = 0; m < 4; ++m) { const int r = row0 + ai * HALF + m * 16; f32x4 ng[2][2];
                    if (ai * 4 + m < 7) { const int g2 = ai * 4 + m + 1; ld_gate(row0 + (g2 >> 2) * HALF + (g2 & 3) * 16, col0, ng); }
                    bf16_t* op = PART + ((size_t)(u.aux - 1) * MS + (size_t)(r - MP)) * D + col0;
#pragma unroll
                    for (int bj = 0; bj < 2; ++bj) st8(op + bj * HALF, cg[bj][0] * acc[ai][bj][m][0], cg[bj][1] * acc[ai][bj][m][1]);
#pragma unroll
                    for (int bj = 0; bj < 2; ++bj)
#pragma unroll
                        for (int n = 0; n < 2; ++n) cg[bj][n] = ng[bj][n];
                }
        }
    }
};
struct EpiSwiglu {
    static constexpr bool PERM = true;
    bf16_t* ACT;
    __device__ __forceinline__ void operator()(f32x4 (&acc)[2][2][4][2], const Unit& u, int wr, int wc, int fr, int fq) const {
        bf16_t* base = ACT + (size_t)(u.pm * BM + wr * 64 + fr) * DFF + u.pn * 128 + wc * 32 + 8 * fq;
#pragma unroll
        for (int ai = 0; ai < 2; ++ai)
#pragma unroll
            for (int m = 0; m < 4; ++m) { f32x4 v0, v1;
#pragma unroll
                for (int j = 0; j < 4; ++j) { v0[j] = siluf_(acc[ai][0][m][0][j]) * acc[ai][1][m][0][j]; v1[j] = siluf_(acc[ai][0][m][1][j]) * acc[ai][1][m][1][j]; }
                st8(base + (size_t)(ai * HALF + m * 16) * DFF, v0, v1); }
    }
};
}

struct Args {
    const float *x_prompt, *x_sample, *state_conv, *c_prompt, *c_sample, *g_mix, *g_ffn, *w_ada, *b_ada, *w_in, *w_conv, *g_v, *w_sg, *b_sg, *w_pa, *w_pb, *w_out, *w_ffn_in, *w_ffn_out, *g_final;
    float* out; unsigned char* ws; int ph_lo, ph_hi, li, pad;
};

struct CopyItem { const float* W; bf16_t* WT; int K, N, k0, n0, drow0; };
__device__ __forceinline__ void copy_load(const CopyItem& c, f32x4 (&v)[16], int lane) {
    const int nl = lane & 15, q = lane >> 4;
#pragma unroll
    for (int i = 0; i < 16; ++i) v[i] = __builtin_nontemporal_load((const f32x4*)(c.W + (size_t)(c.k0 + 16 * q + i) * c.N + c.n0 + 4 * nl));
}
__device__ __forceinline__ void copy_finish(const CopyItem& c, const f32x4 (&v)[16], LAS bf16_t* T, int lane) {
    const int nl = lane & 15, q = lane >> 4;
#pragma unroll
    for (int j = 0; j < 4; ++j) {
        u32x4 p0, p1;
        p0.x = cvt_pk_bf16(v[0][j], v[1][j]); p0.y = cvt_pk_bf16(v[2][j], v[3][j]); p0.z = cvt_pk_bf16(v[4][j], v[5][j]); p0.w = cvt_pk_bf16(v[6][j], v[7][j]);
        p1.x = cvt_pk_bf16(v[8][j], v[9][j]); p1.y = cvt_pk_bf16(v[10][j], v[11][j]); p1.z = cvt_pk_bf16(v[12][j], v[13][j]); p1.w = cvt_pk_bf16(v[14][j], v[15][j]);
        LAS u32x4* dst = (LAS u32x4*)(T + (4 * nl + j) * 72 + 16 * q);
        dst[0] = p0; dst[1] = p1;
    }
    asm volatile("s_waitcnt lgkmcnt(0)" ::: "memory");
    const int kc = (lane & 7) * 8;
#pragma unroll
    for (int jj = 0; jj < 8; ++jj) { const int n = (lane >> 3) + 8 * jj; const u32x4 o = *(const LAS u32x4*)(T + n * 72 + kc); *(u32x4*)(c.WT + (size_t)(c.drow0 + n) * c.K + c.k0 + kc) = o; }
    asm volatile("s_waitcnt lgkmcnt(0)" ::: "memory");
}
__device__ __forceinline__ int win_vrow(int n0) {
    if (n0 < 1024) return n0;
    if (n0 < 2048) { const int q = n0 - 1024; return 1024 + (q >> 7) * 256 + (q & 127); }
    if (n0 < 3072) { const int q = n0 - 2048; return 1024 + (q >> 7) * 256 + 128 + (q & 127); }
    if (n0 < 5120) return n0;
    if (n0 < 7168) { const int q = n0 - 5120; return 5120 + (q >> 7) * 256 + (q & 127); }
    const int q = n0 - 7168; return 5120 + (q >> 7) * 256 + 128 + (q & 127);
}
__device__ __forceinline__ int wfi_vrow(int n0) {
    if (n0 < DFF) return (n0 >> 7) * 256 + (n0 & 127);
    const int q = n0 - DFF; return (q >> 7) * 256 + 128 + (q & 127);
}
constexpr int IT_WIN = (D / 64) * (NIN / 64), IT_WPA = (CD / 64) * (D / 64), IT_WOUT = (D / 64) * (D / 64), IT_WFI = (D / 64) * (NFI / 64), IT_WFO = (DFF / 64) * (D / 64);
constexpr int IT_TOTAL = IT_WIN + 2 * IT_WPA + IT_WOUT + IT_WFI + IT_WFO;
constexpr int SC_ROWS = 144, MOD_ITEMS = NMOD / 64;
constexpr int CW_SCDONE = 192, CW_MODDONE = 256, CW_XQ = 320;
constexpr int MT_STRIDE = 264;

__device__ __forceinline__ CopyItem copy_decode(const Args& a, int it, bf16_t* WIN, bf16_t* WPA, bf16_t* WPB, bf16_t* WOUT, bf16_t* WFI, bf16_t* WFO) {
    CopyItem c;
    if (it < IT_WIN) { const int nb = it % (NIN / 64), kb = it / (NIN / 64); c = CopyItem{a.w_in, WIN, D, NIN, kb * 64, nb * 64, win_vrow(nb * 64)}; return c; } it -= IT_WIN;
    if (it < IT_WPA) { const int nb = it % (D / 64), kb = it / (D / 64); c = CopyItem{a.w_pa, WPA, CD, D, kb * 64, nb * 64, nb * 64}; return c; } it -= IT_WPA;
    if (it < IT_WPA) { const int nb = it % (D / 64), kb = it / (D / 64); c = CopyItem{a.w_pb, WPB, CD, D, kb * 64, nb * 64, nb * 64}; return c; } it -= IT_WPA;
    if (it < IT_WOUT) { const int nb = it % (D / 64), kb = it / (D / 64); c = CopyItem{a.w_out, WOUT, D, D, kb * 64, nb * 64, nb * 64}; return c; } it -= IT_WOUT;
    if (it < IT_WFI) { const int nb = it % (NFI / 64), kb = it / (NFI / 64); c = CopyItem{a.w_ffn_in, WFI, D, NFI, kb * 64, nb * 64, wfi_vrow(nb * 64)}; return c; } it -= IT_WFI;
    { const int nb = it % (D / 64), kb = it / (D / 64); c = CopyItem{a.w_ffn_out, WFO, DFF, D, kb * 64, nb * 64, nb * 64}; return c; }
}

__device__ __forceinline__ void mod_item(const Args& a, const bf16_t* SC, float* MOD, LAS unsigned char* lds, int item, int tid) {
    const int lane = tid & 63, w = __builtin_amdgcn_readfirstlane(tid >> 6), fr = lane & 15, fq = lane >> 4, n0 = item * 64;
    const int c4 = tid & 15, kp = tid >> 4;
    f32x4 acc[2][4];
#pragma unroll
    for (int i = 0; i < 4; ++i) { acc[0][i] = (f32x4){0.f, 0.f, 0.f, 0.f}; acc[1][i] = acc[0][i]; }
    const float* wbase = a.w_ada + n0 + 4 * c4;
    f32x4 wv[8];
#pragma unroll
    for (int j = 0; j < 4; ++j) { const int k = 2 * (kp + 32 * j); wv[2 * j] = __builtin_nontemporal_load((const f32x4*)(wbase + (size_t)k * NMOD)); wv[2 * j + 1] = __builtin_nontemporal_load((const f32x4*)(wbase + (size_t)(k + 1) * NMOD)); }
#pragma unroll 1
    for (int c = 0; c < 8; ++c) {
        LAS bf16_t* T = (LAS bf16_t*)(lds + (c & 1) * (64 * MT_STRIDE * 2));
#pragma unroll
        for (int j = 0; j < 4; ++j) { const int k = 2 * (kp + 32 * j);
#pragma unroll
            for (int i = 0; i < 4; ++i) *(LAS unsigned*)(T + (4 * c4 + i) * MT_STRIDE + k) = cvt_pk_bf16(wv[2 * j][i], wv[2 * j + 1][i]); }
        bf16x8 af[8], af2[8];
#pragma unroll
        for (int ks = 0; ks < 8; ++ks) af[ks] = *(const bf16x8*)(SC + (size_t)(16 * w + fr) * D + c * 256 + ks * 32 + 8 * fq);
        if (w == 0) {
#pragma unroll
            for (int ks = 0; ks < 8; ++ks) af2[ks] = *(const bf16x8*)(SC + (size_t)(128 + fr) * D + c * 256 + ks * 32 + 8 * fq);
        }
        if (c + 1 < 8) {
#pragma unroll
            for (int j = 0; j < 4; ++j) { const int k = (c + 1) * 256 + 2 * (kp + 32 * j); wv[2 * j] = __builtin_nontemporal_load((const f32x4*)(wbase + (size_t)k * NMOD)); wv[2 * j + 1] = __builtin_nontemporal_load((const f32x4*)(wbase + (size_t)(k + 1) * NMOD)); }
        }
        asm volatile("s_waitcnt lgkmcnt(0)" ::: "memory"); __builtin_amdgcn_s_barrier(); asm volatile("" ::: "memory");
#pragma unroll
        for (int ks = 0; ks < 8; ++ks) {
            bf16x8 bfr[4];
#pragma unroll
            for (int nb = 0; nb < 4; ++nb) bfr[nb] = *(const LAS bf16x8*)(T + (16 * nb + fr) * MT_STRIDE + ks * 32 + 8 * fq);
#pragma unroll
            for (int nb = 0; nb < 4; ++nb) acc[0][nb] = __builtin_amdgcn_mfma_f32_16x16x32_bf16(af[ks], bfr[nb], acc[0][nb], 0, 0, 0);
            if (w == 0) {
#pragma unroll
                for (int nb = 0; nb < 4; ++nb) acc[1][nb] = __builtin_amdgcn_mfma_f32_16x16x32_bf16(af2[ks], bfr[nb], acc[1][nb], 0, 0, 0);
            }
        }
    }
#pragma unroll
    for (int nb = 0; nb < 4; ++nb) { const float bias = a.b_ada[n0 + 16 * nb + fr];
#pragma unroll
        for (int e = 0; e < 4; ++e) {
            __hip_atomic_store(MOD + (size_t)(16 * w + 4 * fq + e) * NMOD + n0 + 16 * nb + fr, acc[0][nb][e] + bias, __ATOMIC_RELAXED, __HIP_MEMORY_SCOPE_AGENT);
            if (w == 0 && 128 + 4 * fq + e < MODROWS) __hip_atomic_store(MOD + (size_t)(128 + 4 * fq + e) * NMOD + n0 + 16 * nb + fr, acc[1][nb][e] + bias, __ATOMIC_RELAXED, __HIP_MEMORY_SCOPE_AGENT);
        } }
    asm volatile("s_waitcnt vmcnt(0) lgkmcnt(0)" ::: "memory");
    __syncthreads();
}

__device__ __forceinline__ void row_load(f32x4 (&v)[8], const float* row, int lane) {
#pragma unroll
    for (int j = 0; j < 8; ++j) v[j] = *(const f32x4*)(row + 4 * lane + 256 * j);
}
__device__ __forceinline__ void row_load_nt(f32x4 (&v)[8], const float* row, int lane) {
#pragma unroll
    for (int j = 0; j < 8; ++j) v[j] = __builtin_nontemporal_load((const f32x4*)(row + 4 * lane + 256 * j));
}
__device__ __forceinline__ void row_load_bf16(f32x4 (&v)[8], const bf16_t* row, int lane) {
#pragma unroll
    for (int j = 0; j < 8; ++j) { const u32x2 p = __builtin_nontemporal_load((const u32x2*)(row + 4 * lane + 256 * j)); v[j] = (f32x4){bf_lo(p.x), bf_hi(p.x), bf_lo(p.y), bf_hi(p.y)}; }
}
__device__ __forceinline__ void norm_core_bf16(const f32x4 (&v)[8], const f32x4 (&g)[8], const float* sc, const float* sh, bf16_t* orow, int lane) {
    float s = 0.f;
#pragma unroll
    for (int j = 0; j < 8; ++j) s += (v[j][0] * v[j][0] + v[j][1] * v[j][1]) + (v[j][2] * v[j][2] + v[j][3] * v[j][3]);
    const float rstd = rsqrtf(wave_sum(s) * (1.0f / D) + EPS);
#pragma unroll
    for (int j = 0; j < 8; ++j) { const int c = 4 * lane + 256 * j; const f32x4 a = *(const f32x4*)(sc + c), b = *(const f32x4*)(sh + c);
        const f32x4 o = (v[j] * rstd) * g[j] * (1.0f + a) + b; u32x2 wv; wv.x = cvt_pk_bf16(o[0], o[1]); wv.y = cvt_pk_bf16(o[2], o[3]); *(u32x2*)(orow + c) = wv; }
}
constexpr int TS = 136;
__device__ __forceinline__ void mixer_prompt_pair(const Args& a, LAS unsigned char* lds, int item, int tid, const bf16_t* U, const bf16_t* V, bf16_t* YB, const float* VSS) {
    const int lane = tid & 63, w = tid >> 6, fr = lane & 15, fq = lane >> 4, half = w >> 2, hw = w & 3, htid = tid & 255;
    const int g = item & 7, ch = 2 * ((item >> 3) & 7) + half, b = item >> 6;
    const int m0 = b * SEQ + ch * 128;
    LAS bf16_t* Wc = (LAS bf16_t*)lds; LAS bf16_t* VT = (LAS bf16_t*)(lds + (1 + half) * 128 * TS * 2); LAS float* rs = (LAS float*)(lds + 3 * 128 * TS * 2) + half * 128;
    if (htid < 128) rs[htid] = rsqrtf(VSS[m0 + htid] * (1.0f / CD) + EPS);
    for (int i = tid; i < 128 * 32; i += NTHREADS) { const int t = i >> 5, s4 = (i & 31) * 4; f32x4 wv = *(const f32x4*)(a.w_sg + ((size_t)g * 128 + t) * 128 + s4);
#pragma unroll
        for (int j = 0; j < 4; ++j) if (s4 + j > t) wv[j] = 0.f;
        u32x2 o; o.x = cvt_pk_bf16(wv[0], wv[1]); o.y = cvt_pk_bf16(wv[2], wv[3]); *(LAS u32x2*)(Wc + t * TS + s4) = o; }
    __syncthreads();
#pragma unroll
    for (int it = 0; it < 8; ++it) { const int s = htid & 127, cg = (htid >> 7) + 2 * it, c0 = g * 128 + cg * 8;
        const u32x4 p = *(const u32x4*)(V + (size_t)(m0 + s) * CD + c0); const float r = rs[s];
        const f32x4 g0 = *(const f32x4*)(a.g_v + c0), g1 = *(const f32x4*)(a.g_v + c0 + 4);
        float vn[8] = {bf_lo(p.x) * r * g0[0], bf_hi(p.x) * r * g0[1], bf_lo(p.y) * r * g0[2], bf_hi(p.y) * r * g0[3], bf_lo(p.z) * r * g1[0], bf_hi(p.z) * r * g1[1], bf_lo(p.w) * r * g1[2], bf_hi(p.w) * r * g1[3]};
        if (ch == 15) { float* o = a.out + O_SGVP + ((size_t)(b * 128 + s) * 8 + g) * 128 + cg * 8; *(f32x4*)o = (f32x4){vn[0], vn[1], vn[2], vn[3]}; *(f32x4*)(o + 4) = (f32x4){vn[4], vn[5], vn[6], vn[7]}; }
#pragma unroll
        for (int j = 0; j < 8; j += 2) { const unsigned pk = cvt_pk_bf16(vn[j], vn[j + 1]); VT[(cg * 8 + j) * TS + s] = (bf16_t)(pk & 0xffffu); VT[(cg * 8 + j + 1) * TS + s] = (bf16_t)(pk >> 16); } }
    __syncthreads();
    const int wr = hw >> 1, wc = hw & 1;
    f32x4 acc[4][4];
#pragma unroll
    for (int m = 0; m < 4; ++m)
#pragma unroll
        for (int n = 0; n < 4; ++n) acc[m][n] = (f32x4){0.f, 0.f, 0.f, 0.f};
#pragma unroll
    for (int ks = 0; ks < 4; ++ks) {
        bf16x8 bf[4];
#pragma unroll
        for (int n = 0; n < 4; ++n) bf[n] = *(const LAS bf16x8*)(VT + (wc * 64 + n * 16 + fr) * TS + ks * 32 + fq * 8);
#pragma unroll
        for (int m = 0; m < 4; ++m) { const bf16x8 af = *(const LAS bf16x8*)(Wc + (wr * 64 + m * 16 + fr) * TS + ks * 32 + fq * 8);
#pragma unroll
            for (int n = 0; n < 4; ++n) acc[m][n] = __builtin_amdgcn_mfma_f32_16x16x32_bf16(bf[n], af, acc[m][n], 0, 0, 0); }
    }
#pragma unroll
    for (int m = 0; m < 4; ++m) { const int t = wr * 64 + m * 16 + fr; const float bias = a.b_sg[g * 128 + t]; u32x2 up[4];
#pragma unroll
        for (int n = 0; n < 4; ++n) up[n] = *(const u32x2*)(U + (size_t)(m0 + t) * CD + g * 128 + wc * 64 + n * 16 + 4 * fq);
#pragma unroll
        for (int n = 0; n < 4; ++n) { const size_t off = (size_t)(m0 + t) * CD + g * 128 + wc * 64 + n * 16 + 4 * fq;
            u32x2 o; o.x = cvt_pk_bf16(bf_lo(up[n].x) * (acc[m][n][0] + bias), bf_hi(up[n].x) * (acc[m][n][1] + bias)); o.y = cvt_pk_bf16(bf_lo(up[n].y) * (acc[m][n][2] + bias), bf_hi(up[n].y) * (acc[m][n][3] + bias));
            *(u32x2*)(YB + off) = o; } }
    __syncthreads();
}
__device__ __forceinline__ void mixer_sample_item(const Args& a, LAS unsigned char* lds, int bs, int tid, const bf16_t* U, const bf16_t* V, bf16_t* YB, const float* VSS) {
    const int lane = tid & 63, w = tid >> 6; const int m0 = MP + bs * DSEQ;
    LAS float* rs = (LAS float*)lds;
    if (tid < 4) rs[tid] = rsqrtf(VSS[m0 + tid] * (1.0f / CD) + EPS);
    __syncthreads();
    const int c = 2 * tid, g = c >> 7;
    float vn[4][2];
#pragma unroll
    for (int s = 0; s < 4; ++s) { const unsigned p = *(const unsigned*)(V + (size_t)(m0 + s) * CD + c); const float r = rs[s]; vn[s][0] = bf_lo(p) * r * a.g_v[c]; vn[s][1] = bf_hi(p) * r * a.g_v[c + 1];
        float* o = a.out + O_SGVS + (size_t)(bs * DSEQ + s) * CD + c; o[0] = vn[s][0]; o[1] = vn[s][1]; }
#pragma unroll
    for (int t = 0; t < 4; ++t) { float s0 = a.b_sg[g * 128 + t], s1 = s0;
#pragma unroll
        for (int s = 0; s <= t; ++s) { const float wv = a.w_sg[((size_t)g * 128 + t) * 128 + s]; s0 += wv * vn[s][0]; s1 += wv * vn[s][1]; }
        const unsigned up = *(const unsigned*)(U + (size_t)(m0 + t) * CD + c);
        *(unsigned*)(YB + (size_t)(m0 + t) * CD + c) = cvt_pk_bf16(bf_lo(up) * s0, bf_hi(up) * s1); }
    __syncthreads();
}

__global__ void __launch_bounds__(NTHREADS, 2) fwd_megakernel(Args a) {
    extern __shared__ __attribute__((aligned(16))) unsigned char lds_raw[];
    LAS unsigned char* lds = (LAS unsigned char*)lds_raw;
    const int tid = threadIdx.x, lane = tid & 63, wave = __builtin_amdgcn_readfirstlane(tid >> 6);
    const int G = gridDim.x, bx = blockIdx.x;
    const int gw = bx * 8 + wave, NGW = G * 8;
    unsigned char* ws = a.ws;
    unsigned* ctl = (unsigned*)(ws + WS_CTL);
    float* MOD = (float*)(ws + WS_MOD);
    bf16_t *WIN = (bf16_t*)(ws + WS_WIN), *WPA = (bf16_t*)(ws + WS_WPA), *WPB = (bf16_t*)(ws + WS_WPB), *WOUT = (bf16_t*)(ws + WS_WOUT), *WFI = (bf16_t*)(ws + WS_WFI), *WFO = (bf16_t*)(ws + WS_WFO);
    bf16_t *H = (bf16_t*)(ws + WS_H), *MRG = (bf16_t*)(ws + WS_MRG), *BG = (bf16_t*)(ws + WS_BG), *Z = (bf16_t*)(ws + WS_Z), *U = (bf16_t*)(ws + WS_U), *V = (bf16_t*)(ws + WS_V);
    bf16_t *GA = (bf16_t*)(ws + WS_GA), *GB = (bf16_t*)(ws + WS_GB), *YA = (bf16_t*)(ws + WS_YA), *YB = (bf16_t*)(ws + WS_YB), *ACT = (bf16_t*)(ws + WS_ACT);
    float* X = a.out + O_Y;
    bf16_t* PART5 = (bf16_t*)(ws + WS_ACT + (size_t)M * DFF * 2);
    bf16_t* PART8 = (bf16_t*)(ws + WS_H);
    bf16_t* XB = (bf16_t*)(ws + WS_ACT + (size_t)M * DFF * 2 + (size_t)P5_SPLIT * MS * D * 4);
    bf16_t* SCB = MRG;
    const int lo = a.ph_lo, hi = a.ph_hi;
    volatile LAS unsigned* MISC = (volatile LAS unsigned*)(lds + 131072 + 320);
    if (tid < 32) MISC[tid] = 0u;
    __syncthreads();
    XcdBarrier xbar = xcd_barrier_post(ctl + CW_BAR + XCD_BAR_WORDS * a.li, MISC + 8);
    if (lo < 0) cg::this_grid().sync();
#ifdef ONLY_PHASE
#define IN(k) ((k) == ONLY_PHASE)
#else
#define IN(k) (lo <= (k) && (k) < hi)
#endif
#define SEAM(k) do { if (IN(k) && IN((k) + 1)) { xcd_barrier(xbar); } } while (0)

    if (IN(0)) {
        unsigned* q = ctl + 1024 * a.li;
        if (gw < SC_ROWS) {
            const int it = gw;
            const float* cr = it < NBP ? a.c_prompt + (size_t)it * D : a.c_sample + (size_t)(it - NBP) * D;
#pragma unroll
            for (int j = 0; j < 8; ++j) { const int c = 4 * lane + 256 * j; f32x4 v = (f32x4){0.f, 0.f, 0.f, 0.f}; if (it < MODROWS) v = *(const f32x4*)(cr + c);
                const unsigned long long o = (unsigned long long)cvt_pk_bf16(siluf_(v[0]), siluf_(v[1])) | ((unsigned long long)cvt_pk_bf16(siluf_(v[2]), siluf_(v[3])) << 32);
                __hip_atomic_store((unsigned long long*)(SCB + (size_t)it * D + c), o, __ATOMIC_RELAXED, __HIP_MEMORY_SCOPE_AGENT); }
            asm volatile("s_waitcnt vmcnt(0)" ::: "memory");
            __hip_atomic_fetch_add(q + CW_SCDONE, 1u, __ATOMIC_RELAXED, __HIP_MEMORY_SCOPE_AGENT);
        }
        {
            LAS bf16_t* Te = (LAS bf16_t*)(lds + wave * 16384); constexpr int QNe = IT_TOTAL / 8;
            const int xq = (int)(xb_xcc_id() & 7u); unsigned* qc = q + CW_XQ + 64 * xq;
            int cv = 0; if (lane == 0) cv = (int)atomicAdd(qc, 2u);
            const int c = __builtin_amdgcn_readfirstlane(cv);
            if (c < QNe) { const CopyItem c0 = copy_decode(a, xq * QNe + c, WIN, WPA, WPB, WOUT, WFI, WFO), c1 = copy_decode(a, xq * QNe + c + 1, WIN, WPA, WPB, WOUT, WFI, WFO);
                f32x4 v0[16], v1[16]; copy_load(c0, v0, lane); copy_load(c1, v1, lane); copy_finish(c0, v0, Te, lane); copy_finish(c1, v1, Te, lane); }
        }
        {
            if (lane == 0) { unsigned sp = 0; while (__hip_atomic_load(q + CW_SCDONE, __ATOMIC_RELAXED, __HIP_MEMORY_SCOPE_AGENT) < (unsigned)SC_ROWS * 64u && ++sp < (1u << 22)) __builtin_amdgcn_s_sleep(1); }
            asm volatile("s_waitcnt vmcnt(0)" ::: "memory");
            __syncthreads();
            for (int it0 = bx; it0 < MOD_ITEMS + 64; it0 += G) {
                const int xg = it0 & 7, idx = it0 >> 3; if (idx >= MOD_ITEMS / 8) break; const int it = xg * (MOD_ITEMS / 8) + idx;
                mod_item(a, SCB, MOD, lds, it, tid);
                if (tid == 0) __hip_atomic_fetch_add(q + CW_MODDONE, 1u, __ATOMIC_RELAXED, __HIP_MEMORY_SCOPE_AGENT);
                __syncthreads();
            }
        }
        LAS bf16_t* T = (LAS bf16_t*)(lds + wave * 16384);
        {
            constexpr int QN = IT_TOTAL / 8;
            static_assert(IT_TOTAL % 16 == 0, "queue split");
            const int x0 = (int)(xb_xcc_id() & 7u);
            for (int qi = 0; qi < 8; ++qi) {
                const int xq = (x0 + qi) & 7; unsigned* qc = q + CW_XQ + 64 * xq;
                if ((int)__builtin_amdgcn_readfirstlane(__hip_atomic_load(qc, __ATOMIC_RELAXED, __HIP_MEMORY_SCOPE_AGENT)) >= QN) continue;
                int cv = 0; if (lane == 0) cv = (int)atomicAdd(qc, 2u);
                for (;;) {
                    const int c = __builtin_amdgcn_readfirstlane(cv);
                    if (c >= QN) break;
                    const CopyItem c0 = copy_decode(a, xq * QN + c, WIN, WPA, WPB, WOUT, WFI, WFO), c1 = copy_decode(a, xq * QN + c + 1, WIN, WPA, WPB, WOUT, WFI, WFO);
                    f32x4 v0[16], v1[16];
                    copy_load(c0, v0, lane); copy_load(c1, v1, lane);
                    cv = 0; if (lane == 0) cv = (int)atomicAdd(qc, 2u);
                    copy_finish(c0, v0, T, lane); copy_finish(c1, v1, T, lane);
                }
            }
        }
        {
            if (lane == 0) { unsigned sp = 0; while (__hip_atomic_load(q + CW_MODDONE, __ATOMIC_RELAXED, __HIP_MEMORY_SCOPE_AGENT) < (unsigned)MOD_ITEMS && ++sp < (1u << 22)) __builtin_amdgcn_s_sleep(1); }
            asm volatile("s_waitcnt vmcnt(0)" ::: "memory");
            f32x4 gv[8], v[8]; row_load(gv, a.g_mix, lane);
            if (gw < M) row_load_nt(v, gw < MP ? a.x_prompt + (size_t)gw * D : a.x_sample + (size_t)(gw - MP) * D, lane);
            for (int m = gw; m < M; m += NGW) { const int m2 = m + NGW; f32x4 nv[8];
                if (m2 < M) row_load_nt(nv, m2 < MP ? a.x_prompt + (size_t)m2 * D : a.x_sample + (size_t)(m2 - MP) * D, lane);
                const float* mr = MOD + (size_t)mod_row(m) * NMOD;
                norm_core_bf16(v, gv, mr + 1 * D, mr + 0 * D, H + (size_t)m * D, lane);
#pragma unroll
                for (int j = 0; j < 8; ++j) v[j] = nv[j]; }
        }
    }
    SEAM(1);
    if (IN(2)) {
        pg8::SchedPlain S; S.o.init(M / 256, NIN / 256, G, bx); S.A = (const char*)H; S.B = (const char*)WIN; S.tsA = (size_t)256 * D * 2; S.tsB = (size_t)256 * D * 2; S.nk = D / 64;
        pg8::EpiIn E{BG, Z, U, V, GA, GB, (float*)(ctl + CW_VSS)};
        pg8::gemm_phase(lds, D, D, S, E);
    }
    SEAM(2);
    if (IN(3)) {
        for (int it = bx; it < 256 + NBS; it += G) { if (it < 256) mixer_prompt_pair(a, lds, it, tid, U, V, YB, (const float*)(ctl + CW_VSS)); else mixer_sample_item(a, lds, it - 256, tid, U, V, YB, (const float*)(ctl + CW_VSS)); }
        for (int it = gw; it < (MP / 8) * 2; it += NGW) {
            const int r0 = (it >> 1) * 8, c = (it & 1) * 512 + lane * 8, t0 = r0 & (SEQ - 1);
            u32x4 zr[10], bgr[8];
#pragma unroll
            for (int i = 0; i < 10; ++i) { zr[i] = (u32x4){0u, 0u, 0u, 0u}; if (i >= 2 || t0 > 0) zr[i] = __builtin_nontemporal_load((const u32x4*)(Z + (size_t)(r0 - 2 + i) * CD + c)); }
#pragma unroll
            for (int i = 0; i < 8; ++i) bgr[i] = __builtin_nontemporal_load((const u32x4*)(BG + (size_t)(r0 + i) * CD + c));
            float wk[3][8];
#pragma unroll
            for (int k = 0; k < 3; ++k) { const f32x4 w0 = *(const f32x4*)(a.w_conv + k * CD + c), w1 = *(const f32x4*)(a.w_conv + k * CD + c + 4);
#pragma unroll
                for (int j = 0; j < 4; ++j) { wk[k][j] = w0[j]; wk[k][4 + j] = w1[j]; } }
#pragma unroll
            for (int i = 0; i < 8; ++i) {
                float y[8], zc[8];
#pragma unroll
                for (int j = 0; j < 4; ++j) {
                    const float z0l = bf_lo(zr[i][j]), z0h = bf_hi(zr[i][j]), z1l = bf_lo(zr[i + 1][j]), z1h = bf_hi(zr[i + 1][j]), z2l = bf_lo(zr[i + 2][j]), z2h = bf_hi(zr[i + 2][j]);
                    y[2 * j] = bf_lo(bgr[i][j]) * (wk[0][2 * j] * z0l + wk[1][2 * j] * z1l + wk[2][2 * j] * z2l);
                    y[2 * j + 1] = bf_hi(bgr[i][j]) * (wk[0][2 * j + 1] * z0h + wk[1][2 * j + 1] * z1h + wk[2][2 * j + 1] * z2h);
                    zc[2 * j] = z2l; zc[2 * j + 1] = z2h; }
                u32x4 o; o.x = cvt_pk_bf16(y[0], y[1]); o.y = cvt_pk_bf16(y[2], y[3]); o.z = cvt_pk_bf16(y[4], y[5]); o.w = cvt_pk_bf16(y[6], y[7]);
                *(u32x4*)(YA + (size_t)(r0 + i) * CD + c) = o;
                if (t0 + i >= SEQ - 2) { float* dst = a.out + O_CONVP + ((size_t)(r0 >> 11) * 2 + (t0 + i - (SEQ - 2))) * CD + c;
                    *(f32x4*)dst = (f32x4){zc[0], zc[1], zc[2], zc[3]}; *(f32x4*)(dst + 4) = (f32x4){zc[4], zc[5], zc[6], zc[7]}; }
            }
        }
        for (int idx = MP * 128 + bx * NTHREADS + tid; idx < M * 128; idx += G * NTHREADS) {
            const int r = idx >> 7, c = (idx & 127) * 8;
            int t, S_; const float* pre = nullptr;
            if (r < MP) { t = r & (SEQ - 1); S_ = SEQ; } else { t = (r - MP) & 3; S_ = DSEQ; pre = a.state_conv + (size_t)((r - MP) >> 2) * 2 * CD + c; }
            float z2[8], z1[8], z0[8];
            { const u32x4 p = *(const u32x4*)(Z + (size_t)r * CD + c); z2[0] = bf_lo(p.x); z2[1] = bf_hi(p.x); z2[2] = bf_lo(p.y); z2[3] = bf_hi(p.y); z2[4] = bf_lo(p.z); z2[5] = bf_hi(p.z); z2[6] = bf_lo(p.w); z2[7] = bf_hi(p.w); }
            if (t >= 1) { const u32x4 p = *(const u32x4*)(Z + (size_t)(r - 1) * CD + c); z1[0] = bf_lo(p.x); z1[1] = bf_hi(p.x); z1[2] = bf_lo(p.y); z1[3] = bf_hi(p.y); z1[4] = bf_lo(p.z); z1[5] = bf_hi(p.z); z1[6] = bf_lo(p.w); z1[7] = bf_hi(p.w); }
            else {
#pragma unroll
                for (int j = 0; j < 8; ++j) z1[j] = pre ? pre[CD + j] : 0.f; }
            if (t >= 2) { const u32x4 p = *(const u32x4*)(Z + (size_t)(r - 2) * CD + c); z0[0] = bf_lo(p.x); z0[1] = bf_hi(p.x); z0[2] = bf_lo(p.y); z0[3] = bf_hi(p.y); z0[4] = bf_lo(p.z); z0[5] = bf_hi(p.z); z0[6] = bf_lo(p.w); z0[7] = bf_hi(p.w); }
            else {
#pragma unroll
                for (int j = 0; j < 8; ++j) z0[j] = pre ? pre[t * CD + j] : 0.f; }
            const u32x4 bgp = *(const u32x4*)(BG + (size_t)r * CD + c);
            const float bg[8] = {bf_lo(bgp.x), bf_hi(bgp.x), bf_lo(bgp.y), bf_hi(bgp.y), bf_lo(bgp.z), bf_hi(bgp.z), bf_lo(bgp.w), bf_hi(bgp.w)};
            float y[8];
#pragma unroll
            for (int j = 0; j < 8; ++j) y[j] = bg[j] * (a.w_conv[c + j] * z0[j] + a.w_conv[CD + c + j] * z1[j] + a.w_conv[2 * CD + c + j] * z2[j]);
            u32x4 o; o.x = cvt_pk_bf16(y[0], y[1]); o.y = cvt_pk_bf16(y[2], y[3]); o.z = cvt_pk_bf16(y[4], y[5]); o.w = cvt_pk_bf16(y[6], y[7]);
            *(u32x4*)(YA + (size_t)r * CD + c) = o;
            if (t >= S_ - 2) {
                float* dst = (r < MP) ? a.out + O_CONVP + ((size_t)(r >> 11) * 2 + (t - (S_ - 2))) * CD + c : a.out + O_CONVS + ((size_t)((r - MP) >> 2) * 2 + (t - (S_ - 2))) * CD + c;
                *(f32x4*)dst = (f32x4){z2[0], z2[1], z2[2], z2[3]}; *(f32x4*)(dst + 4) = (f32x4){z2[4], z2[5], z2[6], z2[7]};
            }
        }
    }
    SEAM(3);
    if (IN(4)) {
        pg8::SchedDual S; S.o.init(M / 256, D / 256, G, bx); S.A0 = (const char*)YA; S.B0 = (const char*)WPA; S.A1 = (const char*)YB; S.B1 = (const char*)WPB; S.tsA = (size_t)256 * CD * 2; S.tsB = (size_t)256 * CD * 2; S.nk = CD / 64;
        pg8::EpiMerge E{GA, GB, MRG};
        pg8::gemm_phase(lds, CD, CD, S, E);
    }
    SEAM(4);
    if (IN(5)) {
        pg8::SchedSplit S; S.init(D / 256, P5_SPLIT, (D / 128) / P5_SPLIT, D / 64, G, bx); S.A = (const char*)MRG; S.B = (const char*)WOUT; S.tsA = (size_t)256 * D * 2; S.tsB = (size_t)256 * D * 2;
        pg8::EpiResidSplit<false> E{a.x_prompt, XB, PART5, MOD + 2 * D};
        pg8::gemm_phase(lds, D, D, S, E);
    }
    SEAM(5);
    if (IN(6)) {
        f32x4 gv[8], v[8]; row_load(gv, a.g_ffn, lane);
        const int rstep = NGW > MS ? NGW - MS : NGW; int m = (NGW > MS) ? (gw < MS ? MP + gw : gw - MS) : gw;
        if (m < M) { if (m < MP) row_load_bf16(v, XB + (size_t)m * D, lane); else row_load(v, a.x_sample + (size_t)(m - MP) * D, lane); }
        while (m < M) { int m2 = (NGW > MS) ? (m >= MP ? M : m + rstep) : m + rstep; if (NGW > MS && m2 >= MP) m2 = M; f32x4 nv[8];
            if (m2 < M) { if (m2 < MP) row_load_bf16(nv, XB + (size_t)m2 * D, lane); else row_load(nv, a.x_sample + (size_t)(m2 - MP) * D, lane); }
            if (m >= MP) {
#pragma unroll 4
                for (int q = 0; q < P5_SPLIT; ++q) {
#pragma unroll
                    for (int j = 0; j < 8; ++j) { const u32x2 p = __builtin_nontemporal_load((const u32x2*)(PART5 + ((size_t)q * MS + (m - MP)) * D + 4 * lane + 256 * j)); v[j] += (f32x4){bf_lo(p.x), bf_hi(p.x), bf_lo(p.y), bf_hi(p.y)}; } }
#pragma unroll
                for (int j = 0; j < 8; ++j) { u32x2 o; o.x = cvt_pk_bf16(v[j][0], v[j][1]); o.y = cvt_pk_bf16(v[j][2], v[j][3]); *(u32x2*)(XB + (size_t)m * D + 4 * lane + 256 * j) = o; } }
            const float* mr = MOD + (size_t)mod_row(m) * NMOD;
            norm_core_bf16(v, gv, mr + 4 * D, mr + 3 * D, H + (size_t)m * D, lane);
#pragma unroll
            for (int j = 0; j < 8; ++j) v[j] = nv[j];
            m = m2; }
    }
    SEAM(6);
    if (IN(7)) {
        pg8::SchedPlain S; S.o.init(M / 256, NFI / 256, G, bx); S.A = (const char*)H; S.B = (const char*)WFI; S.tsA = (size_t)256 * D * 2; S.tsB = (size_t)256 * D * 2; S.nk = D / 64;
        pg8::EpiSwiglu E{ACT};
        pg8::gemm_phase(lds, D, D, S, E);
    }
    SEAM(7);
    if (IN(8)) {
        pg8::SchedSplit S; S.init(D / 256, P8_SPLIT, (DFF / 128) / P8_SPLIT, DFF / 64, G, bx); S.A = (const char*)ACT; S.B = (const char*)WFO; S.tsA = (size_t)256 * DFF * 2; S.tsB = (size_t)256 * DFF * 2;
        pg8::EpiResidSplit<true> E{XB, XB, PART8, MOD + 5 * D};
        pg8::gemm_phase(lds, DFF, DFF, S, E);
    }
    SEAM(8);
    if (IN(9)) {
        f32x4 gv[8], v[8]; row_load(gv, a.g_final, lane);
        const int rstep = NGW > MS ? NGW - MS : NGW; int m = (NGW > MS) ? (gw < MS ? MP + gw : gw - MS) : gw;
        if (m < M) row_load_bf16(v, XB + (size_t)m * D, lane);
        while (m < M) { float* xr = X + (size_t)m * D; int m2 = (NGW > MS) ? (m >= MP ? M : m + rstep) : m + rstep; if (NGW > MS && m2 >= MP) m2 = M; f32x4 nv[8];
            if (m2 < M) row_load_bf16(nv, XB + (size_t)m2 * D, lane);
            if (m >= MP) {
#pragma unroll 4
                for (int q = 0; q < P8_SPLIT; ++q) {
#pragma unroll
                    for (int j = 0; j < 8; ++j) { const u32x2 p = __builtin_nontemporal_load((const u32x2*)(PART8 + ((size_t)q * MS + (m - MP)) * D + 4 * lane + 256 * j)); v[j] += (f32x4){bf_lo(p.x), bf_hi(p.x), bf_lo(p.y), bf_hi(p.y)}; } } }
            float s = 0.f;
#pragma unroll
            for (int j = 0; j < 8; ++j) s += (v[j][0] * v[j][0] + v[j][1] * v[j][1]) + (v[j][2] * v[j][2] + v[j][3] * v[j][3]);
            const float rstd = rsqrtf(wave_sum(s) * (1.0f / D) + EPS);
#pragma unroll
            for (int j = 0; j < 8; ++j) { const int c = 4 * lane + 256 * j; __builtin_nontemporal_store((v[j] * rstd) * gv[j], (f32x4*)(xr + c)); }
#pragma unroll
            for (int j = 0; j < 8; ++j) v[j] = nv[j];
            m = m2; }
    }
#undef IN
#undef SEAM
}

extern "C" void kernel_launch(void* const* d_in, const int* in_sizes, int n_in, void* d_out, int out_size, void* d_ws, size_t ws_size, hipStream_t stream) {
    static int grid = 0;
    if (grid == 0) {
        if (n_in != 20 || ws_size < WS_END) { fprintf(stderr, "kernel_launch: need 20 inputs and >= %zu bytes of workspace; got %d, %zu\n", (size_t)WS_END, n_in, ws_size); grid = -1; return; }
        int dev = 0, cus = 0, per_cu = 0;
        if (hipGetDevice(&dev) != hipSuccess || hipDeviceGetAttribute(&cus, hipDeviceAttributeMultiprocessorCount, dev) != hipSuccess) { grid = -1; return; }
        if (hipFuncSetAttribute((const void*)fwd_megakernel, hipFuncAttributeMaxDynamicSharedMemorySize, LDS_BYTES) != hipSuccess) { fprintf(stderr, "kernel_launch: hipFuncSetAttribute failed\n"); grid = -1; return; }
        if (hipOccupancyMaxActiveBlocksPerMultiprocessor(&per_cu, (const void*)fwd_megakernel, NTHREADS, LDS_BYTES) != hipSuccess || per_cu < 1) { fprintf(stderr, "kernel_launch: occupancy query reports %d blocks per CU\n", per_cu); grid = -1; return; }
        grid = cus * 1;
    }
    if (grid < 0) return;
    hipMemsetAsync((char*)d_ws + WS_CTL, 0, CTL_BYTES, stream);
    Args a{};
    a.x_prompt = (const float*)d_in[0]; a.x_sample = (const float*)d_in[1]; a.state_conv = (const float*)d_in[2]; a.c_prompt = (const float*)d_in[3]; a.c_sample = (const float*)d_in[4];
    a.g_mix = (const float*)d_in[5]; a.g_ffn = (const float*)d_in[6]; a.w_ada = (const float*)d_in[7]; a.b_ada = (const float*)d_in[8]; a.w_in = (const float*)d_in[9]; a.w_conv = (const float*)d_in[10];
    a.g_v = (const float*)d_in[11]; a.w_sg = (const float*)d_in[12]; a.b_sg = (const float*)d_in[13]; a.w_pa = (const float*)d_in[14]; a.w_pb = (const float*)d_in[15]; a.w_out = (const float*)d_in[16];
    a.w_ffn_in = (const float*)d_in[17]; a.w_ffn_out = (const float*)d_in[18]; a.g_final = (const float*)d_in[19];
    a.out = (float*)d_out; a.ws = (unsigned char*)d_ws;
#if MK_N_LAUNCHES == 1
    if (PROBE_PHASE < 0) {
        a.ph_lo = 0; a.ph_hi = NPHASE; a.li = 0;
        void* args[] = {&a};
        hipError_t e = hipLaunchCooperativeKernel((const void*)fwd_megakernel, dim3(grid), dim3(NTHREADS), args, LDS_BYTES, stream);
        if (e != hipSuccess) fprintf(stderr, "kernel_launch: cooperative launch failed: %s (grid %d)\n", hipGetErrorString(e), grid);
    } else {
        const int cuts[4] = {0, PROBE_PHASE + 1, PROBE_PHASE + 1, NPHASE};
        for (int li = 0; li < 3; ++li) { a.ph_lo = (li == 1) ? PROBE_PHASE : cuts[li]; a.ph_hi = cuts[li + 1]; a.li = li; if (a.ph_lo >= a.ph_hi) continue;
            void* args[] = {&a};
            hipError_t e = hipLaunchCooperativeKernel((const void*)fwd_megakernel, dim3(grid), dim3(NTHREADS), args, LDS_BYTES, stream);
            if (e != hipSuccess) fprintf(stderr, "kernel_launch: cooperative launch failed: %s (grid %d)\n", hipGetErrorString(e), grid); }
    }
#else
    for (int p = 0; p < NPHASE; ++p) { a.ph_lo = p; a.ph_hi = p + 1; a.li = 0; hipLaunchKernelGGL(fwd_megakernel, dim3(grid), dim3(NTHREADS), LDS_BYTES, stream, a); }
#endif
}
```
